# Optimizing an MI355X kernel written in HIP

```python
import jax, jax.numpy as jnp
from jax import lax
import numpy as np

D_MODEL = 2048
BATCH = 4
SEQ = 8192
DEPTH = 1
DEC_BATCH = 32
DEC_SEQ = 64
PAST_LEN = 2048

CHUNK = 64
E_POOL = 1024
N_POOL_GROUPS = 4
POOL_GROUP = E_POOL // N_POOL_GROUPS
POOL_WINDOWS = (2, 4, 8, 16)
POOL_BUF = max(POOL_WINDOWS) - 1
E_CONV = 1024
CONV_WIDTH = 3
CONV_BUF = CONV_WIDTH - 1
SPLIT_SIZES = (E_POOL, E_POOL, E_CONV, E_CONV, E_CONV, E_CONV, D_MODEL, D_MODEL)
IN_COLS = sum(SPLIT_SIZES)
SPLIT_IDX = tuple(int(i) for i in np.cumsum(SPLIT_SIZES)[:-1])
EPS = 1e-6

kernel_name = 'hybrid_pool_shortconv_gated_stream_step'


def rmsnorm(x, g):
    xf = x.astype(jnp.float32)
    r = lax.rsqrt(jnp.mean(xf * xf, axis=-1, keepdims=True) + EPS)
    return (xf * r * g.astype(jnp.float32)).astype(x.dtype)


def pool_mixer(xa, buf, offset, w_mix, scale):
    B, T, _ = xa.shape
    xp = jnp.concatenate([buf.astype(xa.dtype), xa], axis=1).astype(jnp.float32)
    cs = jnp.pad(jnp.cumsum(xp, axis=1), ((0, 0), (1, 0), (0, 0)))
    pos = offset + jnp.arange(T, dtype=jnp.int32)
    outs = []
    for g, w in enumerate(POOL_WINDOWS):
        sl = slice(g * POOL_GROUP, (g + 1) * POOL_GROUP)
        s = cs[:, POOL_BUF + 1:POOL_BUF + 1 + T, sl] - cs[:, POOL_BUF + 1 - w:POOL_BUF + 1 - w + T, sl]
        cnt = jnp.minimum(pos + 1, w).astype(jnp.float32)[None, :, None]
        outs.append(s / cnt - xp[:, POOL_BUF:, sl])
    d = jnp.stack(outs, axis=2)
    mixed = jnp.einsum('btgc,gcd->btgd', d, w_mix.astype(jnp.float32))
    y = mixed.reshape(B, T, E_POOL) * scale.astype(jnp.float32)
    return y.astype(xa.dtype), xp[:, -POOL_BUF:].astype(xa.dtype)


def conv_mixer(u, buf, w_conv):
    T = u.shape[1]
    up = jnp.concatenate([buf.astype(u.dtype), u], axis=1)
    y = w_conv[0] * up[:, 0:T] + w_conv[1] * up[:, 1:1 + T] + w_conv[2] * up[:, 2:2 + T]
    return y, up[:, -CONV_BUF:]


def layer(x, pool_buf, conv_buf, offset, norm_g, w_in, b_gate, w_pool_mix, pool_scale,
          w_conv, w_proj_pool, w_proj_conv, w_out):
    h = rmsnorm(x, norm_g)
    proj = jnp.einsum('btd,dc->btc', h, w_in)
    xa, za, v, bg, cg, zb, ga, gb = jnp.split(proj, SPLIT_IDX, axis=-1)
    ya, new_pool = pool_mixer(xa, pool_buf, offset, w_pool_mix, pool_scale)
    ya = ya * jax.nn.silu(za)
    yc, new_conv = conv_mixer(cg * v, conv_buf, w_conv)
    yb = bg * yc * jax.nn.silu(zb)
    merged = (jax.nn.sigmoid(ga + b_gate[:D_MODEL]) * jnp.einsum('bte,ed->btd', ya, w_proj_pool)
              + jax.nn.sigmoid(gb + b_gate[D_MODEL:]) * jnp.einsum('bte,ed->btd', yb, w_proj_conv))
    x = x + jnp.einsum('btd,de->bte', merged, w_out)
    return x, new_pool, new_conv


def trunk(x, pool_bufs, conv_bufs, offset, norm_g, w_in, b_gate, w_pool_mix, pool_scale,
          w_conv, w_proj_pool, w_proj_conv, w_out, final_norm_g):
    new_pools, new_convs = [], []
    for l in range(DEPTH):
        x, npool, nconv = layer(x, pool_bufs[l], conv_bufs[l], offset, norm_g[l], w_in[l], b_gate[l],
                                w_pool_mix[l], pool_scale[l], w_conv[l], w_proj_pool[l],
                                w_proj_conv[l], w_out[l])
        new_pools.append(npool)
        new_convs.append(nconv)
    return rmsnorm(x, final_norm_g), jnp.stack(new_pools, axis=0), jnp.stack(new_convs, axis=0)


def setup_inputs(seed: int = 0) -> dict:
    key = jax.random.key(seed)
    ks = jax.random.split(key, 14)
    f32 = jnp.float32
    return {
        'x_prompt': jax.random.normal(ks[0], (BATCH, SEQ, D_MODEL), f32),
        'x_sample': jax.random.normal(ks[1], (DEC_BATCH, DEC_SEQ, D_MODEL), f32),
        'state_pool': jax.random.normal(ks[2], (DEPTH, DEC_BATCH, POOL_BUF, E_POOL), f32),
        'state_conv': jax.random.normal(ks[3], (DEPTH, DEC_BATCH, CONV_BUF, E_CONV), f32),
        'norm_g': 1.0 + 0.02 * jax.random.normal(ks[4], (DEPTH, D_MODEL), f32),
        'w_in': jax.random.normal(ks[5], (DEPTH, D_MODEL, IN_COLS), f32) * D_MODEL ** -0.5,
        'b_gate': 0.02 * jax.random.normal(ks[6], (DEPTH, 2 * D_MODEL), f32),
        'w_pool_mix': jax.random.normal(ks[7], (DEPTH, N_POOL_GROUPS, POOL_GROUP, POOL_GROUP), f32) * POOL_GROUP ** -0.5,
        'pool_scale': 1.0 + 0.02 * jax.random.normal(ks[8], (DEPTH, E_POOL), f32),
        'w_conv': jax.random.normal(ks[9], (DEPTH, CONV_WIDTH, E_CONV), f32) * CONV_WIDTH ** -0.5,
        'w_proj_pool': jax.random.normal(ks[10], (DEPTH, E_POOL, D_MODEL), f32) * E_POOL ** -0.5,
        'w_proj_conv': jax.random.normal(ks[11], (DEPTH, E_CONV, D_MODEL), f32) * E_CONV ** -0.5,
        'w_out': jax.random.normal(ks[12], (DEPTH, D_MODEL, D_MODEL), f32) * D_MODEL ** -0.5,
        'final_norm_g': 1.0 + 0.02 * jax.random.normal(ks[13], (D_MODEL,), f32),
    }


def reference(x_prompt, x_sample, state_pool, state_conv, norm_g, w_in, b_gate, w_pool_mix,
              pool_scale, w_conv, w_proj_pool, w_proj_conv, w_out, final_norm_g):
    bp = x_prompt.shape[0]
    zero_pool = jnp.zeros((DEPTH, bp, POOL_BUF, E_POOL), x_prompt.dtype)
    zero_conv = jnp.zeros((DEPTH, bp, CONV_BUF, E_CONV), x_prompt.dtype)
    y_prompt, new_pool_prompt, new_conv_prompt = trunk(
        x_prompt, zero_pool, zero_conv, 0, norm_g, w_in, b_gate, w_pool_mix, pool_scale,
        w_conv, w_proj_pool, w_proj_conv, w_out, final_norm_g)
    y_sample, new_pool_sample, new_conv_sample = trunk(
        x_sample, state_pool, state_conv, PAST_LEN, norm_g, w_in, b_gate, w_pool_mix, pool_scale,
        w_conv, w_proj_pool, w_proj_conv, w_out, final_norm_g)
    return (y_prompt, y_sample, new_pool_prompt, new_conv_prompt, new_pool_sample, new_conv_sample)
```

```cpp
#include <hip/hip_runtime.h>
#include <hip/hip_cooperative_groups.h>
#include <cstdio>
namespace cg = cooperative_groups;

#define LAS __attribute__((address_space(3)))
typedef unsigned short bf16_t;
typedef short bf16x8 __attribute__((ext_vector_type(8)));
typedef float f32x4 __attribute__((ext_vector_type(4)));
typedef unsigned u32x4 __attribute__((ext_vector_type(4)));
typedef unsigned u32x2 __attribute__((ext_vector_type(2)));
typedef int i32x4 __attribute__((ext_vector_type(4)));
typedef int i32x8 __attribute__((ext_vector_type(8)));

constexpr int D = 2048, TP = 32768, TS = 2048, T = TP + TS;
constexpr int NIN = 10240;
constexpr int LDP = 2048 + 64;
constexpr float EPS = 1e-6f;
constexpr int LD8 = 2048 + 128;
constexpr float W8_SCALE = 64.0f;
constexpr int BM = 256, BK = 64, HALF = 128, HTB = HALF * BK * 2, STAGE_BYTES = 8 * HTB;
constexpr int NTHREADS = 512;
constexpr int LDS_BYTES = STAGE_BYTES + 256;

constexpr size_t O_Y = 0, O_NPP = 71303168, O_NCP = 71364608, O_NPS = 71372800, O_NCS = 71864320;
constexpr size_t WS_H = 0;
constexpr size_t WS_BIN = WS_H + (size_t)T * LDP * 2;
constexpr size_t WS_BP = WS_BIN + (size_t)11264 * LDP * 2;
constexpr size_t WS_BO = WS_BP + (size_t)2048 * LDP * 2;
constexpr size_t WS_XM = WS_BO + (size_t)2048 * LDP * 2;
constexpr size_t WS_SA = WS_XM + (size_t)T * 1024 * 2;
constexpr size_t WS_U = WS_SA + (size_t)T * 1024 * 2;
constexpr size_t WS_G2 = WS_U + (size_t)T * 1024 * 2;
constexpr size_t WS_SGR = WS_G2 + (size_t)T * 1024 * 2;
constexpr size_t WS_SGB = WS_SGR + (size_t)T * 2048 * 2;
constexpr size_t WS_BUFM = WS_SGB + (size_t)T * 2048 * 2;
constexpr size_t WS_SS = WS_BUFM + (size_t)32 * 15 * 1024 * 4;
constexpr size_t WS_BAR = WS_SS + (size_t)T * 32 * 4;
constexpr size_t WS_CMAX = WS_BAR + 16384;
constexpr size_t WS_CMAXW = WS_CMAX + 10240 * 4;
constexpr size_t ZERO_BYTES = 16384 + 10240 * 4 + 1024 * 4;
constexpr size_t WS_H8 = WS_CMAXW + 1024 * 4;
constexpr size_t WS_BIN8 = WS_H8 + (size_t)T * LD8;
constexpr size_t WS_H8I = WS_BIN8 + (size_t)4096 * LD8;
constexpr size_t WS_BIN8I = WS_H8I + (size_t)T * LD8;
constexpr size_t WS_CSV = WS_BIN8I + (size_t)6144 * LD8;
constexpr size_t WS_RSC = WS_CSV + 6144 * 4;
constexpr size_t WS_HG = WS_RSC + (size_t)T * 4;
constexpr size_t WS_END = WS_HG + (size_t)256 * LDP * 2;
constexpr size_t WS_MG = WS_XM;

struct Params {
    const float *xp, *xs, *spool, *sconv, *ng, *win, *bgate, *wmix, *pscale, *wconv, *wpp, *wpc, *wout, *fng;
    float* out; unsigned char* ws;
};

typedef float f32x2_t __attribute__((ext_vector_type(2)));
typedef __bf16 bf16x2_t __attribute__((ext_vector_type(2)));
__device__ __forceinline__ unsigned pk_bf16(float lo, float hi) { const f32x2_t v = {lo, hi}; return __builtin_bit_cast(unsigned, __builtin_convertvector(v, bf16x2_t)); }
__device__ __forceinline__ unsigned pk_fp8x4(float a, float b, float c, float d) { int w = 0; w = __builtin_amdgcn_cvt_pk_fp8_f32(a, b, w, false); w = __builtin_amdgcn_cvt_pk_fp8_f32(c, d, w, true); return (unsigned)w; }
__device__ __forceinline__ unsigned pk_i8x4(float a, float b, float c, float d) {
    const int q0 = (int)rintf(a), q1 = (int)rintf(b), q2 = (int)rintf(c), q3 = (int)rintf(d);
    return (unsigned)(q0 & 255) | ((unsigned)(q1 & 255) << 8) | ((unsigned)(q2 & 255) << 16) | ((unsigned)q3 << 24); }
__device__ __forceinline__ float bf_lo(unsigned w) { return __uint_as_float(w << 16); }
__device__ __forceinline__ float bf_hi(unsigned w) { return __uint_as_float(w & 0xffff0000u); }
__device__ __forceinline__ float sigmoid_f(float x) { x = fminf(fmaxf(x, -40.f), 40.f); return __builtin_amdgcn_rcpf(1.0f + __builtin_amdgcn_exp2f(-1.44269504f * x)); }
__device__ __forceinline__ float silu_f(float x) { return x * sigmoid_f(x); }

__device__ __forceinline__ int lds_byte(int r, int c) { const int st = (r >> 4) * 2 + (c >> 5), rr = r & 15, cc = c & 31, ob = rr * 64 + cc * 2; return st * 1024 + (ob ^ (((ob >> 9) & 1) << 5)); }
__device__ __forceinline__ void stage_rc(int b, int& R, int& C) { const int st = b / 1024, sb = b % 1024, swz = sb ^ (((sb >> 9) & 1) << 5); R = (st >> 1) * 16 + swz / 64; C = (st & 1) * 32 + (swz % 64) / 2; }
__device__ __forceinline__ int perm32(int rho) { const int n = rho >> 4, i = rho & 15; return 8 * (i >> 2) + 4 * n + (i & 3); }

struct Unit { int pm, pn, kh, type; };
struct GemmDesc { const bf16_t* A; const bf16_t* Bt; int lda, ldb, nt; const bf16_t* A2; const bf16_t* Bt2; };

__device__ __forceinline__ void tile_map(int L, int nM, int nN, int& pm, int& pn) {
    const int nwg = nM * nN; int wgid = L;
    { const int q = nwg / 8, r = nwg % 8, xcd = wgid % 8, off = wgid / 8; wgid = (xcd < r ? xcd * (q + 1) : r * (q + 1) + (xcd - r) * q) + off; }
    const int nig = 8 * nN, gid = wgid / nig, fm = gid * 8, gsz = (nM - fm) < 8 ? (nM - fm) : 8;
    pm = fm + ((wgid % nig) % gsz); pn = (wgid % nig) / gsz;
}

template <int MODE  , class Epi, class Sched>
__device__ __forceinline__ void gemm_phase(LAS unsigned char* lds, const GemmDesc g, const Sched& S, const Epi& E) {
    int tid_ = threadIdx.x; asm volatile("" : "+v"(tid_));
    const int tid = tid_, wid = __builtin_amdgcn_readfirstlane(tid >> 6), lane = tid & 63, wr = wid >> 2, wc = wid & 3, fr = lane & 15, fq = lane >> 4;
    const int nt = g.nt;
    unsigned voffA[2], voffB[2];
#pragma unroll
    for (int i = 0; i < 2; ++i) { int R, C; stage_rc(tid * 16 + i * 8192, R, C); const int Rb = (R & ~31) + perm32(R & 31);
        voffA[i] = (unsigned)(R * g.lda + C) * 2u; voffB[i] = (unsigned)(Rb * g.ldb + C) * 2u; }
    const size_t kstep = (size_t)(BK * 2);
    const size_t hstepA = (size_t)HALF * g.lda * 2, hstepB = (size_t)HALF * g.ldb * 2;
    const size_t khb = (size_t)nt * kstep;
    const unsigned ldsw = (unsigned)wid * 1024u;
    const int aoff = lds_byte(wr * 64 + fr, fq * 8), boff = lds_byte(wc * 32 + fr, fq * 8);
#define G_SA(b, h) (((b) * 2 + (h)) * HTB)
#define G_SB(b, h) ((4 + (b) * 2 + (h)) * HTB)
#define G_STAGE(bufoff, gbase, voff) do { _Pragma("unroll") for (int _i = 0; _i < 2; ++_i) \
        __builtin_amdgcn_global_load_lds((const unsigned*)((const char*)(gbase) + (voff)[_i]), (LAS unsigned*)(lds + (bufoff) + ldsw + _i * 8192), 16, 0, 0); } while (0)
#define G_LDA(dst, b, h) do { if constexpr (MODE == 1) { _Pragma("unroll") for (int m = 0; m < 4; ++m) { dst##8[m].lo = *(const LAS i32x4*)(lds + G_SA(b, h) + aoff + m * 2048); dst##8[m].hi = *(const LAS i32x4*)(lds + G_SA(b, h) + aoff + m * 2048 + 1024); } } \
        else { _Pragma("unroll") for (int m = 0; m < 4; ++m) _Pragma("unroll") for (int k = 0; k < 2; ++k) dst[m][k] = *(const LAS bf16x8*)(lds + G_SA(b, h) + aoff + m * 2048 + k * 1024); } } while (0)
#define G_LDB(dst, b, h) do { if constexpr (MODE == 1) { _Pragma("unroll") for (int n = 0; n < 2; ++n) { dst##8[n].lo = *(const LAS i32x4*)(lds + G_SB(b, h) + boff + n * 2048); dst##8[n].hi = *(const LAS i32x4*)(lds + G_SB(b, h) + boff + n * 2048 + 1024); } } \
        else { _Pragma("unroll") for (int n = 0; n < 2; ++n) _Pragma("unroll") for (int k = 0; k < 2; ++k) dst[n][k] = *(const LAS bf16x8*)(lds + G_SB(b, h) + boff + n * 2048 + k * 1024); } } while (0)
#define G_MMA(ai, bj, At, Bt) do { __builtin_amdgcn_s_setprio(1); \
        if constexpr (MODE == 1) { _Pragma("unroll") for (int m = 0; m < 4; ++m) _Pragma("unroll") for (int n = 0; n < 2; ++n) \
            asm volatile("v_mfma_scale_f32_16x16x128_f8f6f4 %0, %1, %2, %0, %3, %3 op_sel_hi:[0,0,0]" : "+v"(acc[ai][bj][m][n]) : "v"(Bt##8[n]), "v"(At##8[m]), "v"(one_scale)); } \
        else { _Pragma("unroll") for (int m = 0; m < 4; ++m) _Pragma("unroll") for (int n = 0; n < 2; ++n) _Pragma("unroll") for (int k = 0; k < 2; ++k) \
            { if constexpr (MODE == 2) acc[ai][bj][m][n] = __builtin_bit_cast(f32x4, __builtin_amdgcn_mfma_i32_16x16x64_i8(__builtin_bit_cast(i32x4, Bt[n][k]), __builtin_bit_cast(i32x4, At[m][k]), __builtin_bit_cast(i32x4, acc[ai][bj][m][n]), 0, 0, 0)); \
              else acc[ai][bj][m][n] = __builtin_amdgcn_mfma_f32_16x16x32_bf16(Bt[n][k], At[m][k], acc[ai][bj][m][n], 0, 0, 0); } } \
        __builtin_amdgcn_s_setprio(0); } while (0)
#define G_WAIT_V(n) asm volatile("s_waitcnt vmcnt(" #n ")" ::: "memory")
#define G_WAIT_L(n) asm volatile("s_waitcnt lgkmcnt(" #n ")" ::: "memory")
#define G_BAR __builtin_amdgcn_s_barrier()
#define G_SCHED __builtin_amdgcn_sched_barrier(0)
    Unit cur, nxt; int ui = 0;
    if (!S.next(0, cur)) return;
    f32x4 acc[2][2][4][2];
#pragma unroll
    for (int a = 0; a < 2; ++a)
#pragma unroll
        for (int b = 0; b < 2; ++b)
#pragma unroll
            for (int m = 0; m < 4; ++m)
#pragma unroll
                for (int n = 0; n < 2; ++n) acc[a][b][m][n] = (f32x4){0.f, 0.f, 0.f, 0.f};
    bf16x8 At[4][2], B0[2][2], B1[2][2];
    const int one_scale = 0x7f7f7f7f;
    i32x8 At8[4], B08[2], B18[2];
    const char* cA = (const char*)(cur.type ? g.A2 : g.A) + (size_t)cur.pm * 2 * hstepA + (size_t)cur.kh * khb;
    const char* cB = (const char*)(cur.type ? g.Bt2 : g.Bt) + (size_t)cur.pn * 2 * hstepB + (size_t)cur.kh * khb;
    G_STAGE(G_SB(0, 0), cB, voffB); G_STAGE(G_SA(0, 0), cA, voffA); G_STAGE(G_SB(0, 1), cB + hstepB, voffB); G_STAGE(G_SA(0, 1), cA + hstepA, voffA);
    if (wr == 1) G_BAR;
    G_WAIT_V(4); G_BAR;
    G_STAGE(G_SB(1, 0), cB + kstep, voffB); G_STAGE(G_SA(1, 0), cA + kstep, voffA); G_STAGE(G_SB(1, 1), cB + hstepB + kstep, voffB);
    G_WAIT_V(6); G_BAR;
    for (;;) {
        const bool has_next = S.next(ui + 1, nxt);
        const char* nA = has_next ? (const char*)(nxt.type ? g.A2 : g.A) + (size_t)nxt.pm * 2 * hstepA + (size_t)nxt.kh * khb : cA;
        const char* nB = has_next ? (const char*)(nxt.type ? g.Bt2 : g.Bt) + (size_t)nxt.pn * 2 * hstepB + (size_t)nxt.kh * khb : cB;
        for (int t = 0; t < nt; t += 2) {
            const bool last = (t == nt - 2);
            const char* a1 = cA + (size_t)(t + 1) * kstep;
            const char* a2 = last ? nA : cA + (size_t)(t + 2) * kstep; const char* b2 = last ? nB : cB + (size_t)(t + 2) * kstep;
            const char* a3 = a2 + kstep; const char* b3 = b2 + kstep;
            G_LDB(B0, 0, 0); G_SCHED; G_LDA(At, 0, 0); G_STAGE(G_SA(1, 1), a1 + hstepA, voffA);
            G_WAIT_L(8); G_BAR; G_WAIT_L(0); G_MMA(0, 0, At, B0); G_BAR; G_SCHED;
            G_LDB(B1, 0, 1); G_STAGE(G_SB(0, 0), b2, voffB);
            G_BAR; G_WAIT_L(0); G_MMA(0, 1, At, B1); G_BAR;
            G_LDA(At, 0, 1); G_STAGE(G_SA(0, 0), a2, voffA);
            G_BAR; G_WAIT_L(0); G_MMA(1, 0, At, B0); G_BAR; G_SCHED;
            G_STAGE(G_SB(0, 1), b2 + hstepB, voffB);
            G_WAIT_V(6); G_BAR; G_MMA(1, 1, At, B1); G_BAR;
            G_LDB(B0, 1, 0); G_SCHED; G_LDA(At, 1, 0); G_STAGE(G_SA(0, 1), a2 + hstepA, voffA);
            G_WAIT_L(8); G_BAR; G_WAIT_L(0); G_MMA(0, 0, At, B0); G_BAR; G_SCHED;
            G_LDB(B1, 1, 1); G_STAGE(G_SB(1, 0), b3, voffB);
            G_BAR; G_WAIT_L(0); G_MMA(0, 1, At, B1); G_BAR;
            G_LDA(At, 1, 1); G_STAGE(G_SA(1, 0), a3, voffA);
            G_BAR; G_WAIT_L(0); G_MMA(1, 0, At, B0); G_BAR; G_SCHED;
            G_STAGE(G_SB(1, 1), b3 + hstepB, voffB);
            G_WAIT_V(6); G_BAR; G_MMA(1, 1, At, B1); G_BAR;
        }
        if constexpr (MODE == 1) asm volatile("s_nop 15\n\ts_nop 15" ::: "memory");
        const bool zero = E(acc, cur, wr, wc, fr, fq);
        if (!has_next) break;
        if (zero) {
#pragma unroll
            for (int a = 0; a < 2; ++a)
#pragma unroll
                for (int b = 0; b < 2; ++b)
#pragma unroll
                    for (int m = 0; m < 4; ++m)
#pragma unroll
                        for (int n = 0; n < 2; ++n) acc[a][b][m][n] = (f32x4){0.f, 0.f, 0.f, 0.f};
        }
        cur = nxt; cA = nA; cB = nB; ++ui;
    }
    G_WAIT_V(0);
    if (wr == 0) G_BAR;
    G_BAR;
#undef G_SA
#undef G_SB
#undef G_STAGE
#undef G_LDA
#undef G_LDB
#undef G_MMA
#undef G_WAIT_V
#undef G_WAIT_L
#undef G_BAR
#undef G_SCHED
}

struct Sched1a {
    int G, c;
    __device__ __forceinline__ bool next(int i, Unit& u) const {
        int L = i * G + c; u.kh = 0; u.type = 0;
        if (L < 48) { const int e = L >> 2; u.pm = e < 4 ? e * 32 + 31 : 124 + e; u.pn = 40 + (L & 3); return true; }
        L -= 48; if (L >= 8) return false;
        u.pm = 0; u.pn = 8 + L; u.type = 1; return true;
    }
};
struct Sched1c {
    int G, c;
    __device__ __forceinline__ bool next(int i, Unit& u) const { const int L = i * G + (G - 1 - c); if (L >= 3264) return false; tile_map(L, 136, 24, u.pm, u.pn); u.pn += 4;     u.kh = 0; u.type = 0; return true; }
};
struct Sched1b {
    int G, c;
    __device__ __forceinline__ bool next(int i, Unit& u) const { const int L = i * G + (G - 1 - c); if (L >= 2176) return false; tile_map(L, 136, 16, u.pm, u.pn); u.pn += 24; u.kh = 0; u.type = 0; return true; }
};
struct SchedA {
    int G, c;
    __device__ __forceinline__ bool next(int i, Unit& u) const { const int L = (i >> 1) * G + c; if (L >= 1024) return false; tile_map(L, 128, 8, u.pm, u.pn); u.kh = i & 1; u.type = 0; return true; }
};
struct SchedB {
    int G, c;
    __device__ __forceinline__ bool next(int i, Unit& u) const { const int L = (i >> 1) * G + c; if (L >= 1024) return false; u.kh = i & 1;
        if (L < 960) { tile_map(L, 120, 8, u.pm, u.pn); u.type = 1; } else { tile_map(L - 960, 8, 8, u.pm, u.pn); u.pm += 128; u.type = 0; }
        return true; }
};
struct SchedC {
    int G, c;
    __device__ __forceinline__ bool next(int i, Unit& u) const { const int L = (i >> 1) * G + c; if (L >= 128) return false; tile_map(L, 16, 8, u.pm, u.pn); u.pm += 120; u.kh = i & 1; u.type = 1; return true; }
};

struct Epi1 {
    bf16_t *XM, *SA, *U, *G2; float* out;
    __device__ __forceinline__ bool operator()(f32x4 (&acc)[2][2][4][2], const Unit& u, int wr, int wc, int fr, int fq) const {
        const int pn = u.pn, r0 = u.pm * BM + wr * 64 + fr, cl = wc * 32 + fq * 8;
        if (pn < 8) {
            bf16_t* O = pn < 4 ? XM : SA; const bool act = pn >= 4; const int c0 = (pn & 3) * 256 + cl;
#pragma unroll
            for (int ai = 0; ai < 2; ++ai)
#pragma unroll
                for (int m = 0; m < 4; ++m) { bf16_t* rowp = O + (size_t)(r0 + ai * HALF + m * 16) * 1024 + c0;
#pragma unroll
                    for (int bj = 0; bj < 2; ++bj) { f32x4 v0 = acc[ai][bj][m][0], v1 = acc[ai][bj][m][1];
                        if (act) {
#pragma unroll
                            for (int j = 0; j < 4; ++j) { v0[j] = silu_f(v0[j]); v1[j] = silu_f(v1[j]); } }
                        u32x4 w; w.x = pk_bf16(v0[0], v0[1]); w.y = pk_bf16(v0[2], v0[3]); w.z = pk_bf16(v1[0], v1[1]); w.w = pk_bf16(v1[2], v1[3]);
                        __builtin_nontemporal_store(w, (u32x4*)(rowp + bj * HALF)); } }
        } else if (pn < 24) {
            const bool isvc = pn < 16; bf16_t* O = isvc ? U : G2; const int ch0 = ((pn - 8) & 7) * 128 + cl;
#pragma unroll
            for (int ai = 0; ai < 2; ++ai)
#pragma unroll
                for (int m = 0; m < 4; ++m) { const int row = r0 + ai * HALF + m * 16;
                    f32x4 v0, v1; const f32x4 a0 = acc[ai][0][m][0], a1 = acc[ai][0][m][1], b0 = acc[ai][1][m][0], b1 = acc[ai][1][m][1];
                    if (isvc) { v0 = a0 * b0; v1 = a1 * b1; }
                    else {
#pragma unroll
                        for (int j = 0; j < 4; ++j) { v0[j] = a0[j] * silu_f(b0[j]); v1[j] = a1[j] * silu_f(b1[j]); } }
                    u32x4 w; w.x = pk_bf16(v0[0], v0[1]); w.y = pk_bf16(v0[2], v0[3]); w.z = pk_bf16(v1[0], v1[1]); w.w = pk_bf16(v1[2], v1[3]);
                    if (u.type == 1) {
                        if (row < 72) { float* dst = (row < 8 ? out + O_NCP + (size_t)row * 1024 : out + O_NCS + (size_t)(row - 8) * 1024) + ch0; *(f32x4*)dst = v0; *(f32x4*)(dst + 4) = v1; } }
                    else __builtin_nontemporal_store(w, (u32x4*)(O + (size_t)row * 1024 + ch0)); }
        } else {
            const bool samp = u.pm >= 128; const int c0 = (pn - 40) * 256 + cl;
            if (fr >= 1) {
#pragma unroll
                for (int ai = 0; ai < 2; ++ai) {
                    if (samp || (ai == 1 && wr == 1)) { const int row = r0 + ai * HALF + 48;
                        float* dst = samp ? out + O_NPS + ((size_t)((row - TP) >> 6) * 15 + (fr - 1)) * 1024 + c0 : out + O_NPP + ((size_t)(row >> 13) * 15 + (fr - 1)) * 1024 + c0;
#pragma unroll
                        for (int bj = 0; bj < 2; ++bj) { *(f32x4*)(dst + bj * HALF) = acc[ai][bj][3][0]; *(f32x4*)(dst + bj * HALF + 4) = acc[ai][bj][3][1]; } } }
            }
        }
        return true;
    }
};

struct EpiI8 {
    bf16_t *SA, *U, *G2; const float* rsc; const float* csv;
    __device__ __forceinline__ bool operator()(f32x4 (&acc)[2][2][4][2], const Unit& u, int wr, int wc, int fr, int fq) const {
        const int pn = u.pn, r0 = u.pm * BM + wr * 64 + fr, cl = wc * 32 + fq * 8;
        const float* cq = csv + (pn - 4) * 256 + cl;
        const f32x4 c00 = *(const f32x4*)(cq), c01 = *(const f32x4*)(cq + 4), c10 = *(const f32x4*)(cq + HALF), c11 = *(const f32x4*)(cq + HALF + 4);
        const int kind = pn < 8 ? 0 : (pn < 16 ? 1 : (pn < 24 ? 2 : 3));
        bf16_t* O = SA + (ptrdiff_t)(kind == 3 ? -1 : kind) * ((ptrdiff_t)T * 1024);
        const int c0 = (kind == 0 || kind == 3) ? (pn & 3) * 256 + cl : ((pn - 8) & 7) * 128 + cl;
#pragma unroll
        for (int ai = 0; ai < 2; ++ai)
#pragma unroll
            for (int m = 0; m < 4; ++m) { const int row = r0 + ai * HALF + m * 16; const float rq = rsc[row];
                const i32x4 i00 = __builtin_bit_cast(i32x4, acc[ai][0][m][0]), i01 = __builtin_bit_cast(i32x4, acc[ai][0][m][1]), i10 = __builtin_bit_cast(i32x4, acc[ai][1][m][0]), i11 = __builtin_bit_cast(i32x4, acc[ai][1][m][1]);
                f32x4 a0, a1, b0, b1;
#pragma unroll
                for (int j = 0; j < 4; ++j) { a0[j] = (float)i00[j] * (rq * c00[j]); a1[j] = (float)i01[j] * (rq * c01[j]); b0[j] = (float)i10[j] * (rq * c10[j]); b1[j] = (float)i11[j] * (rq * c11[j]); }
                if (kind == 0 || kind == 3) {
                    if (kind == 0) {
#pragma unroll
                        for (int j = 0; j < 4; ++j) { a0[j] = silu_f(a0[j]); a1[j] = silu_f(a1[j]); b0[j] = silu_f(b0[j]); b1[j] = silu_f(b1[j]); } }
                    u32x4 w; w.x = pk_bf16(a0[0], a0[1]); w.y = pk_bf16(a0[2], a0[3]); w.z = pk_bf16(a1[0], a1[1]); w.w = pk_bf16(a1[2], a1[3]);
                    __builtin_nontemporal_store(w, (u32x4*)(O + (size_t)row * 1024 + c0));
                    w.x = pk_bf16(b0[0], b0[1]); w.y = pk_bf16(b0[2], b0[3]); w.z = pk_bf16(b1[0], b1[1]); w.w = pk_bf16(b1[2], b1[3]);
                    __builtin_nontemporal_store(w, (u32x4*)(O + (size_t)row * 1024 + c0 + HALF));
                } else { f32x4 v0, v1;
                    if (kind == 1) { v0 = a0 * b0; v1 = a1 * b1; }
                    else {
#pragma unroll
                        for (int j = 0; j < 4; ++j) { v0[j] = a0[j] * silu_f(b0[j]); v1[j] = a1[j] * silu_f(b1[j]); } }
                    u32x4 w; w.x = pk_bf16(v0[0], v0[1]); w.y = pk_bf16(v0[2], v0[3]); w.z = pk_bf16(v1[0], v1[1]); w.w = pk_bf16(v1[2], v1[3]);
                    __builtin_nontemporal_store(w, (u32x4*)(O + (size_t)row * 1024 + c0)); } }
        return true;
    }
};
struct EpiGG {
    bf16_t *SGR, *SGB; const float* bgate; float gsc;
    __device__ __forceinline__ bool operator()(f32x4 (&acc)[2][2][4][2], const Unit& u, int wr, int wc, int fr, int fq) const {
        const int pn = u.pn, r0 = u.pm * BM + wr * 64 + fr, cl = wc * 32 + fq * 8;
        {
            const int ch0 = (pn - 24) * 128 + cl;
            const f32x4 ba0 = *(const f32x4*)(bgate + ch0), ba1 = *(const f32x4*)(bgate + ch0 + 4), bb0 = *(const f32x4*)(bgate + D + ch0), bb1 = *(const f32x4*)(bgate + D + ch0 + 4);
#pragma unroll
            for (int ai = 0; ai < 2; ++ai)
#pragma unroll
                for (int m = 0; m < 4; ++m) { const int row = r0 + ai * HALF + m * 16;
                    const f32x4 a0 = acc[ai][0][m][0] * gsc + ba0, a1 = acc[ai][0][m][1] * gsc + ba1, b0 = acc[ai][1][m][0] * gsc + bb0, b1 = acc[ai][1][m][1] * gsc + bb1;
                    f32x4 r0v, r1v, s0v, s1v;
#pragma unroll
                    for (int j = 0; j < 4; ++j) {
                        const float ea0 = __builtin_amdgcn_exp2f(-1.44269504f * fminf(fmaxf(a0[j], -40.f), 40.f)), eb0 = __builtin_amdgcn_exp2f(-1.44269504f * fminf(fmaxf(b0[j], -40.f), 40.f));
                        const float ea1 = __builtin_amdgcn_exp2f(-1.44269504f * fminf(fmaxf(a1[j], -40.f), 40.f)), eb1 = __builtin_amdgcn_exp2f(-1.44269504f * fminf(fmaxf(b1[j], -40.f), 40.f));
                        s0v[j] = __builtin_amdgcn_rcpf(1.0f + eb0); s1v[j] = __builtin_amdgcn_rcpf(1.0f + eb1);
                        r0v[j] = (1.0f + eb0) * __builtin_amdgcn_rcpf(1.0f + ea0); r1v[j] = (1.0f + eb1) * __builtin_amdgcn_rcpf(1.0f + ea1); }
                    u32x4 w; w.x = pk_bf16(r0v[0], r0v[1]); w.y = pk_bf16(r0v[2], r0v[3]); w.z = pk_bf16(r1v[0], r1v[1]); w.w = pk_bf16(r1v[2], r1v[3]);
                    __builtin_nontemporal_store(w, (u32x4*)(SGR + (size_t)row * D + ch0));
                    w.x = pk_bf16(s0v[0], s0v[1]); w.y = pk_bf16(s0v[2], s0v[3]); w.z = pk_bf16(s1v[0], s1v[1]); w.w = pk_bf16(s1v[2], s1v[3]);
                    __builtin_nontemporal_store(w, (u32x4*)(SGB + (size_t)row * D + ch0)); }
        }
        return true;
    }
};

struct EpiD {
    const bf16_t *SGR, *SGB; bf16_t* MG;
    __device__ __forceinline__ bool operator()(f32x4 (&acc)[2][2][4][2], const Unit& u, int wr, int wc, int fr, int fq) const {
        const int r0 = u.pm * BM + wr * 64 + fr, c0 = u.pn * BM + wc * 32 + fq * 8;
        const bf16_t* S = u.kh ? SGB : SGR;
#pragma unroll
        for (int ai = 0; ai < 2; ++ai)
#pragma unroll
            for (int m = 0; m < 4; ++m) { const size_t off = (size_t)(r0 + ai * HALF + m * 16) * D + c0;
#pragma unroll
                for (int bj = 0; bj < 2; ++bj) { const u32x4 s = *(const u32x4*)(S + off + bj * HALF);
                    f32x4 v0 = acc[ai][bj][m][0], v1 = acc[ai][bj][m][1];
                    v0[0] *= bf_lo(s.x); v0[1] *= bf_hi(s.x); v0[2] *= bf_lo(s.y); v0[3] *= bf_hi(s.y);
                    v1[0] *= bf_lo(s.z); v1[1] *= bf_hi(s.z); v1[2] *= bf_lo(s.w); v1[3] *= bf_hi(s.w);
                    acc[ai][bj][m][0] = v0; acc[ai][bj][m][1] = v1; } }
        if (u.kh == 0) return false;
#pragma unroll
        for (int ai = 0; ai < 2; ++ai)
#pragma unroll
            for (int m = 0; m < 4; ++m) { const size_t off = (size_t)(r0 + ai * HALF + m * 16) * LDP + c0;
#pragma unroll
                for (int bj = 0; bj < 2; ++bj) { const f32x4 v0 = acc[ai][bj][m][0], v1 = acc[ai][bj][m][1];
                    u32x4 w; w.x = pk_bf16(v0[0], v0[1]); w.y = pk_bf16(v0[2], v0[3]); w.z = pk_bf16(v1[0], v1[1]); w.w = pk_bf16(v1[2], v1[3]);
                    __builtin_nontemporal_store(w, (u32x4*)(MG + off + bj * HALF)); } }
        return true;
    }
};

struct EpiE {
    bf16_t* DL;
    __device__ __forceinline__ bool operator()(f32x4 (&acc)[2][2][4][2], const Unit& u, int wr, int wc, int fr, int fq) const {
        const int r0 = u.pm * BM + wr * 64 + fr, c0 = u.pn * BM + wc * 32 + fq * 8;
#pragma unroll
        for (int ai = 0; ai < 2; ++ai)
#pragma unroll
            for (int m = 0; m < 4; ++m) { bf16_t* rowp = DL + (size_t)(r0 + ai * HALF + m * 16) * LDP + c0;
#pragma unroll
                for (int bj = 0; bj < 2; ++bj) { const f32x4 v0 = acc[ai][bj][m][0], v1 = acc[ai][bj][m][1];
                    u32x4 w; w.x = pk_bf16(v0[0], v0[1]); w.y = pk_bf16(v0[2], v0[3]); w.z = pk_bf16(v1[0], v1[1]); w.w = pk_bf16(v1[2], v1[3]);
                    __builtin_nontemporal_store(w, (u32x4*)(rowp + bj * HALF)); } }
        return true;
    }
};

struct EpiMix {
    EpiD d; EpiE e;
    __device__ __forceinline__ bool operator()(f32x4 (&acc)[2][2][4][2], const Unit& u, int wr, int wc, int fr, int fq) const {
        if (u.type == 0) return d(acc, u, wr, wc, fr, fq);
        if (u.kh == 0) return false;
        return e(acc, u, wr, wc, fr, fq);
    }
};

struct TrJob { const float* src; bf16_t* dst; int sld; unsigned char* dst8; unsigned char* dst8i; const float* cm; float* csv; int wr16; };
__device__ __forceinline__ int win_srccol(int vch) {
    const int pn = vch >> 2, q = vch & 3, bj = q >> 1, cl0 = (q & 1) * 64;
    if (pn < 8) return 1024 + 256 * (pn - 4) + q * 64;
    if (pn < 16) return (bj ? 4096 : 2048) + 128 * (pn - 8) + cl0;
    if (pn < 24) return (bj ? 5120 : 3072) + 128 * (pn - 16) + cl0;
    if (pn < 40) return (bj ? 8192 : 6144) + 128 * (pn - 24) + cl0;
    return 256 * (pn - 40) + q * 64;
}
__device__ __forceinline__ TrJob tr_job(const Params& p, int j) {
    TrJob t;
    t.dst8 = nullptr; t.dst8i = nullptr; t.cm = nullptr; t.csv = nullptr; t.wr16 = 1;
    if (j < 5120) { const int vch = 16 + (j >> 5), kc = j & 31; t.src = p.win + (size_t)(kc * 64) * NIN + win_srccol(vch); t.sld = NIN; t.dst = (bf16_t*)(p.ws + WS_BIN) + (size_t)(vch * 64) * LDP + kc * 64;
        if (vch >= 96 && vch < 160) { t.dst8 = p.ws + WS_BIN8 + (size_t)((vch - 96) * 64) * LD8 + kc * 64; t.wr16 = 0; }
        if (vch < 96) { t.dst8i = p.ws + WS_BIN8I + (size_t)((vch - 16) * 64) * LD8 + kc * 64; t.cm = (const float*)(p.ws + WS_CMAX) + win_srccol(vch);
            if (kc == 0) t.csv = (float*)(p.ws + WS_CSV) + (vch - 16) * 64;
            t.wr16 = (vch >= 32 && vch < 64) ? 1 : 0; } }
    else if (j < 6144) { const int jj = j - 5120, nc = jj >> 5, kc = jj & 31;
        t.src = (kc < 16 ? p.wpp + (size_t)(kc * 64) * D : p.wpc + (size_t)((kc - 16) * 64) * D) + nc * 64; t.sld = D; t.dst = (bf16_t*)(p.ws + WS_BP) + (size_t)(nc * 64) * LDP + kc * 64; }
    else { const int jj = j - 6144, nc = jj >> 5, kc = jj & 31; t.src = p.wout + (size_t)(kc * 64) * D + nc * 64; t.sld = D; t.dst = (bf16_t*)(p.ws + WS_BO) + (size_t)(nc * 64) * LDP + kc * 64; }
    return t;
}
__device__ __forceinline__ void tr_load4(const Params& p, int j0, int tid, f32x4 (&v)[4][2]) {
#pragma unroll
    for (int q = 0; q < 4; ++q) { const TrJob t = tr_job(p, j0 + q);
#pragma unroll
        for (int i = 0; i < 2; ++i) { const int idx = tid + i * 512, kr = idx >> 4, c4 = idx & 15; v[q][i] = *(const f32x4*)(t.src + (size_t)kr * t.sld + c4 * 4); } }
}
__device__ __forceinline__ void tr_all(const Params& p, LAS float* sm, int b, int G, int tid) {
    f32x4 v[4][2];
    int jb = b;
    if (jb < 1792) tr_load4(p, jb * 4, tid, v);
    while (jb < 1792) {
#pragma unroll
        for (int q = 0; q < 4; ++q)
#pragma unroll
            for (int i = 0; i < 2; ++i) { const int idx = tid + i * 512, kr = idx >> 4, c4 = idx & 15; LAS float* d = sm + q * 4160 + kr * 65 + c4 * 4; d[0] = v[q][i][0]; d[1] = v[q][i][1]; d[2] = v[q][i][2]; d[3] = v[q][i][3]; }
        __syncthreads();
        const int nb = jb + G;
        if (nb < 1792) tr_load4(p, nb * 4, tid, v);
        const int kg = tid & 7, c = tid >> 3;
#pragma unroll 1
        for (int q = 0; q < 4; ++q) { const TrJob t = tr_job(p, jb * 4 + q);
            float f[8];
#pragma unroll
            for (int i = 0; i < 8; ++i) f[i] = sm[q * 4160 + (kg * 8 + i) * 65 + c];
            if (t.dst8) { u32x2 w8; w8.x = pk_fp8x4(f[0] * W8_SCALE, f[1] * W8_SCALE, f[2] * W8_SCALE, f[3] * W8_SCALE); w8.y = pk_fp8x4(f[4] * W8_SCALE, f[5] * W8_SCALE, f[6] * W8_SCALE, f[7] * W8_SCALE);
                *(u32x2*)(t.dst8 + (size_t)c * LD8 + kg * 8) = w8; }
            if (t.dst8i) { const float cmx = t.cm[c], sc = cmx > 0.f ? 127.0f / cmx : 0.f;
                u32x2 w8; w8.x = pk_i8x4(f[0] * sc, f[1] * sc, f[2] * sc, f[3] * sc); w8.y = pk_i8x4(f[4] * sc, f[5] * sc, f[6] * sc, f[7] * sc);
                *(u32x2*)(t.dst8i + (size_t)c * LD8 + kg * 8) = w8;
                if (t.csv && kg == 0) t.csv[c] = cmx * (1.0f / 127.0f); }
            if (t.wr16) { u32x4 w; w.x = pk_bf16(f[0], f[1]); w.y = pk_bf16(f[2], f[3]); w.z = pk_bf16(f[4], f[5]); w.w = pk_bf16(f[6], f[7]);
                *(u32x4*)(t.dst + (size_t)c * LDP + kg * 8) = w; } }
        __syncthreads();
        jb = nb;
    }
}

template <bool TRANS>
__device__ __forceinline__ void mm_tile(LAS float* sm, int tid, const float* __restrict__ A, int lda, int r0, int rmax, int acol0, const float* __restrict__ Wm, int d0, void* dstv, int ldd, int n0, unsigned* cmaxw) {
    LAS float* As = sm; LAS float* Bt = sm + 64 * 68;
    const int lane = tid & 63, w = tid >> 6, fr = lane & 15, fq = lane >> 4, br = w >> 1, bc0 = (w & 1) * 2;
    f32x4 acc0 = (f32x4){0.f, 0.f, 0.f, 0.f}, acc1 = (f32x4){0.f, 0.f, 0.f, 0.f};
    f32x4 va[2], vb[2];
#pragma unroll
    for (int i = 0; i < 2; ++i) { const int idx = tid + i * 512, rr = idx >> 4, c4 = idx & 15;
        va[i] = (f32x4){0.f, 0.f, 0.f, 0.f}; if (r0 + rr < rmax) va[i] = *(const f32x4*)(A + (size_t)(r0 + rr) * lda + acol0 + c4 * 4);
        vb[i] = *(const f32x4*)(Wm + (size_t)rr * 256 + d0 + c4 * 4); }
    for (int cc = 0; cc < 256; cc += 64) {
#pragma unroll
        for (int i = 0; i < 2; ++i) { const int idx = tid + i * 512, rr = idx >> 4, c4 = idx & 15;
            *(LAS f32x4*)(As + rr * 68 + c4 * 4) = va[i];
            LAS float* q = Bt + (c4 * 4) * 68 + rr; q[0] = vb[i][0]; q[68] = vb[i][1]; q[136] = vb[i][2]; q[204] = vb[i][3]; }
        __syncthreads();
        if (cc + 64 < 256) {
#pragma unroll
            for (int i = 0; i < 2; ++i) { const int idx = tid + i * 512, rr = idx >> 4, c4 = idx & 15;
                va[i] = (f32x4){0.f, 0.f, 0.f, 0.f}; if (r0 + rr < rmax) va[i] = *(const f32x4*)(A + (size_t)(r0 + rr) * lda + acol0 + cc + 64 + c4 * 4);
                vb[i] = *(const f32x4*)(Wm + (size_t)(cc + 64 + rr) * 256 + d0 + c4 * 4); } }
#pragma unroll
        for (int ks = 0; ks < 2; ++ks) {
            const LAS float* ap = As + (br * 16 + fr) * 68 + ks * 32 + fq * 8;
            const f32x4 a0 = *(const LAS f32x4*)ap, a1 = *(const LAS f32x4*)(ap + 4);
            u32x4 aw; aw.x = pk_bf16(a0[0], a0[1]); aw.y = pk_bf16(a0[2], a0[3]); aw.z = pk_bf16(a1[0], a1[1]); aw.w = pk_bf16(a1[2], a1[3]);
            const bf16x8 af = __builtin_bit_cast(bf16x8, aw);
#pragma unroll
            for (int bb = 0; bb < 2; ++bb) {
                const LAS float* bp = Bt + ((bc0 + bb) * 16 + fr) * 68 + ks * 32 + fq * 8;
                const f32x4 b0 = *(const LAS f32x4*)bp, b1 = *(const LAS f32x4*)(bp + 4);
                u32x4 bw; bw.x = pk_bf16(b0[0], b0[1]); bw.y = pk_bf16(b0[2], b0[3]); bw.z = pk_bf16(b1[0], b1[1]); bw.w = pk_bf16(b1[2], b1[3]);
                const bf16x8 bf = __builtin_bit_cast(bf16x8, bw);
                if (bb == 0) acc0 = __builtin_amdgcn_mfma_f32_16x16x32_bf16(af, bf, acc0, 0, 0, 0);
                else acc1 = __builtin_amdgcn_mfma_f32_16x16x32_bf16(af, bf, acc1, 0, 0, 0);
            }
        }
        __syncthreads();
    }
#pragma unroll
    for (int bb = 0; bb < 2; ++bb) { const f32x4 cacc = bb ? acc1 : acc0; const int d = (bc0 + bb) * 16 + fr, rl = br * 16 + fq * 4;
        if (TRANS) { bf16_t* dst = (bf16_t*)dstv; u32x2 wv; wv.x = pk_bf16(cacc[0], cacc[1]); wv.y = pk_bf16(cacc[2], cacc[3]);
            *(u32x2*)(dst + (size_t)(n0 + d) * ldd + r0 + rl) = wv;
            float mx = fmaxf(fmaxf(fabsf(cacc[0]), fabsf(cacc[1])), fmaxf(fabsf(cacc[2]), fabsf(cacc[3])));
            mx = fmaxf(mx, __shfl_xor(mx, 16)); mx = fmaxf(mx, __shfl_xor(mx, 32));
            if (fq == 0 && cmaxw) atomicMax(cmaxw + n0 + d, __float_as_uint(mx)); }
        else { float* dst = (float*)dstv;
#pragma unroll
            for (int e = 0; e < 4; ++e) if (r0 + rl + e < rmax) dst[(size_t)(r0 + rl + e) * ldd + n0 + d] = cacc[e]; } }
}
template <int NR>
__device__ __forceinline__ void p0_rows(const Params& p, int r, int nw, int lane) {
    bf16_t* H = (bf16_t*)(p.ws + WS_H);
    f32x4 v[NR][8];
#pragma unroll
    for (int k = 0; k < NR; ++k) { const int row = r + k * nw; const float* x = row < TP ? p.xp + (size_t)row * D : p.xs + (size_t)(row - TP) * D;
#pragma unroll
        for (int i = 0; i < 4; ++i) { v[k][2 * i] = *(const f32x4*)(x + (i * 64 + lane) * 8); v[k][2 * i + 1] = *(const f32x4*)(x + (i * 64 + lane) * 8 + 4); } }
#pragma unroll
    for (int k = 0; k < NR; ++k) { const int row = r + k * nw; float ss = 0.f;
#pragma unroll
        for (int i = 0; i < 8; ++i) ss += (v[k][i][0] * v[k][i][0] + v[k][i][1] * v[k][i][1]) + (v[k][i][2] * v[k][i][2] + v[k][i][3] * v[k][i][3]);
#pragma unroll
        for (int o = 32; o >= 1; o >>= 1) ss += __shfl_xor(ss, o);
        const float rs = rsqrtf(ss * (1.0f / D) + EPS);
        float amax = 0.f;
#pragma unroll
        for (int i = 0; i < 4; ++i) { const f32x4 g0 = *(const f32x4*)(p.ng + (i * 64 + lane) * 8), g1 = *(const f32x4*)(p.ng + (i * 64 + lane) * 8 + 4);
            v[k][2 * i] = v[k][2 * i] * rs * g0; v[k][2 * i + 1] = v[k][2 * i + 1] * rs * g1;
#pragma unroll
            for (int j = 0; j < 4; ++j) amax = fmaxf(amax, fmaxf(fabsf(v[k][2 * i][j]), fabsf(v[k][2 * i + 1][j]))); }
#pragma unroll
        for (int o = 32; o >= 1; o >>= 1) amax = fmaxf(amax, __shfl_xor(amax, o));
        const float qs = amax > 0.f ? 127.0f / amax : 0.f;
        if (lane == 0) ((float*)(p.ws + WS_RSC))[row] = amax * (1.0f / 127.0f);
        int gidx = -1; const int pmr = row >> 8; const bool need16 = pmr >= 128 || (pmr & 31) == 31;
        if (row < TP) { const int pos = row & 8191; if (pos >= 8190) gidx = (row >> 13) * 2 + (pos - 8190); }
        else { const int rsq = row - TP, pos = rsq & 63; if (pos >= 62) gidx = 8 + (rsq >> 6) * 2 + (pos - 62); }
#pragma unroll
        for (int i = 0; i < 4; ++i) { const f32x4 a = v[k][2 * i], c = v[k][2 * i + 1];
            u32x4 w; w.x = pk_bf16(a[0], a[1]); w.y = pk_bf16(a[2], a[3]); w.z = pk_bf16(c[0], c[1]); w.w = pk_bf16(c[2], c[3]);
            if (need16) *(u32x4*)(H + (size_t)row * LDP + (i * 64 + lane) * 8) = w;
            u32x2 w8; w8.x = pk_fp8x4(a[0], a[1], a[2], a[3]); w8.y = pk_fp8x4(c[0], c[1], c[2], c[3]);
            *(u32x2*)(p.ws + WS_H8 + (size_t)row * LD8 + (i * 64 + lane) * 8) = w8;
            u32x2 wi; wi.x = pk_i8x4(a[0] * qs, a[1] * qs, a[2] * qs, a[3] * qs); wi.y = pk_i8x4(c[0] * qs, c[1] * qs, c[2] * qs, c[3] * qs);
            *(u32x2*)(p.ws + WS_H8I + (size_t)row * LD8 + (i * 64 + lane) * 8) = wi;
            if (gidx >= 0) *(u32x4*)((bf16_t*)(p.ws + WS_HG) + (size_t)gidx * LDP + (i * 64 + lane) * 8) = w; } }
}

__device__ __forceinline__ void phase_colmax(const Params& p, LAS unsigned char* lds) {
    LAS f32x4* red = (LAS f32x4*)lds;
    unsigned* cm = (unsigned*)(p.ws + WS_CMAX);
    const int t = threadIdx.x, cq = t % 80, sg = t / 80;
    for (int blk = blockIdx.x; blk < 256; blk += gridDim.x) {
        const int rg = blk >> 4, cb = blk & 15, col = 1024 + cb * 320 + cq * 4;
        f32x4 m = (f32x4){0.f, 0.f, 0.f, 0.f};
        if (sg < 6) for (int r = rg * 128 + sg; r < rg * 128 + 128; r += 6) { const f32x4 v = *(const f32x4*)(p.win + (size_t)r * NIN + col);
            m[0] = fmaxf(m[0], fabsf(v[0])); m[1] = fmaxf(m[1], fabsf(v[1])); m[2] = fmaxf(m[2], fabsf(v[2])); m[3] = fmaxf(m[3], fabsf(v[3])); }
        if (sg < 6) red[sg * 80 + cq] = m;
        __syncthreads();
        if (sg == 0) {
#pragma unroll
            for (int k = 1; k < 6; ++k) { const f32x4 o = red[k * 80 + cq]; m[0] = fmaxf(m[0], o[0]); m[1] = fmaxf(m[1], o[1]); m[2] = fmaxf(m[2], o[2]); m[3] = fmaxf(m[3], o[3]); }
#pragma unroll
            for (int j = 0; j < 4; ++j) atomicMax(cm + col + j, __float_as_uint(m[j]));
        }
        __syncthreads();
    }
    { int t2 = threadIdx.x; asm volatile("" : "+v"(t2));
      for (int j = blockIdx.x; j < 512; j += gridDim.x) { const int kc = j >> 4, dc = j & 15, g = dc >> 2, d0 = (dc & 3) * 64;
        mm_tile<true>((LAS float*)lds, t2, p.win, NIN, kc * 64, 2048, g * 256, p.wmix + (size_t)g * 65536, d0, (bf16_t*)(p.ws + WS_BIN), LDP, g * 256 + d0, (unsigned*)(p.ws + WS_CMAXW)); } }
    if (blockIdx.x == 0) { u32x4 z = (u32x4){0u, 0u, 0u, 0u}; u32x4* hg = (u32x4*)(p.ws + WS_HG + (size_t)72 * LDP * 2);
        for (int i = threadIdx.x; i < (256 - 72) * LDP * 2 / 16; i += NTHREADS) hg[i] = z; }
}

__device__ __forceinline__ void phase0(const Params& p, LAS unsigned char* lds) {
    LAS float* sm = (LAS float*)lds;
    int t_ = threadIdx.x; asm volatile("" : "+v"(t_));
    const int G = gridDim.x, b = blockIdx.x, tid = t_, lane = tid & 63, wid = tid >> 6;
    bf16_t* BIN = (bf16_t*)(p.ws + WS_BIN);
    for (int d = b * 8 + wid; d < 1024; d += G * 8) {
        const float cmx = ((const float*)(p.ws + WS_CMAXW))[d], sc = cmx > 0.f ? 127.0f / cmx : 0.f;
        const u32x4* src = (const u32x4*)(BIN + (size_t)d * LDP + lane * 32);
        u32x4 o[2];
#pragma unroll
        for (int h = 0; h < 2; ++h) { const u32x4 w0 = src[2 * h], w1 = src[2 * h + 1];
            o[h].x = pk_i8x4(bf_lo(w0.x) * sc, bf_hi(w0.x) * sc, bf_lo(w0.y) * sc, bf_hi(w0.y) * sc); o[h].y = pk_i8x4(bf_lo(w0.z) * sc, bf_hi(w0.z) * sc, bf_lo(w0.w) * sc, bf_hi(w0.w) * sc);
            o[h].z = pk_i8x4(bf_lo(w1.x) * sc, bf_hi(w1.x) * sc, bf_lo(w1.y) * sc, bf_hi(w1.y) * sc); o[h].w = pk_i8x4(bf_lo(w1.z) * sc, bf_hi(w1.z) * sc, bf_lo(w1.w) * sc, bf_hi(w1.w) * sc); }
        u32x4* dst = (u32x4*)(p.ws + WS_BIN8I + (size_t)(5120 + d) * LD8 + lane * 32);
        dst[0] = o[0]; dst[1] = o[1];
        if (lane == 0) ((float*)(p.ws + WS_CSV))[5120 + d] = cmx * (1.0f / 127.0f);
    }
    for (int j = b; j < 128; j += G) { const int rc = j >> 4, dc = j & 15, g = dc >> 2, d0 = (dc & 3) * 64;
        mm_tile<false>(sm, tid, p.spool, 1024, rc * 64, 480, g * 256, p.wmix + (size_t)g * 65536, d0, (float*)(p.ws + WS_BUFM), 1024, g * 256 + d0, nullptr); }
    tr_all(p, sm, b, G, tid);
    const int gw = b * 8 + wid, nw = G * 8;
    int r = gw;
    for (; r + nw < T; r += 2 * nw) p0_rows<2>(p, r, nw, lane);
    if (r < T) p0_rows<1>(p, r, nw, lane);
}

template <bool SAMPLE>
__device__ __forceinline__ void stencil_run(const Params& p, int seq, int t0, int nT, int c0) {
    const bf16_t* __restrict__ XM = (const bf16_t*)(p.ws + WS_XM); const bf16_t* __restrict__ SA = (const bf16_t*)(p.ws + WS_SA);
    const bf16_t* __restrict__ U = (const bf16_t*)(p.ws + WS_U); const bf16_t* __restrict__ G2 = (const bf16_t*)(p.ws + WS_G2);
    const float* __restrict__ BUFM = (const float*)(p.ws + WS_BUFM);
    bf16_t* __restrict__ YC = (bf16_t*)(p.ws + WS_H);
    const int rowbase = SAMPLE ? TP + seq * 64 : seq * 8192;
    const int w = 2 << (c0 >> 8);
    float sp[8], um1[8], um2[8], sc[8], w0[8], w1[8], w2[8];
#pragma unroll
    for (int j = 0; j < 8; ++j) { sp[j] = 0.f; sc[j] = p.pscale[c0 + j]; w0[j] = p.wconv[c0 + j]; w1[j] = p.wconv[1024 + c0 + j]; w2[j] = p.wconv[2048 + c0 + j]; }
    for (int i = 1; i < w; ++i) { const int t = t0 - i;
        if (t >= 0) { const u32x4 v = *(const u32x4*)(XM + (size_t)(rowbase + t) * 1024 + c0);
            sp[0] += bf_lo(v.x); sp[1] += bf_hi(v.x); sp[2] += bf_lo(v.y); sp[3] += bf_hi(v.y); sp[4] += bf_lo(v.z); sp[5] += bf_hi(v.z); sp[6] += bf_lo(v.w); sp[7] += bf_hi(v.w); }
        else if (SAMPLE) { const float* q = BUFM + (size_t)(seq * 15 + 15 + t) * 1024 + c0;
#pragma unroll
            for (int j = 0; j < 8; ++j) sp[j] += q[j]; } }
#pragma unroll
    for (int k = 1; k <= 2; ++k) { const int t = t0 - k; float tmp[8];
        if (t >= 0) { const u32x4 v = *(const u32x4*)(U + (size_t)(rowbase + t) * 1024 + c0);
            tmp[0] = bf_lo(v.x); tmp[1] = bf_hi(v.x); tmp[2] = bf_lo(v.y); tmp[3] = bf_hi(v.y); tmp[4] = bf_lo(v.z); tmp[5] = bf_hi(v.z); tmp[6] = bf_lo(v.w); tmp[7] = bf_hi(v.w); }
        else if (SAMPLE) { const float* q = p.sconv + (size_t)(seq * 2 + 2 + t) * 1024 + c0;
#pragma unroll
            for (int j = 0; j < 8; ++j) tmp[j] = q[j]; }
        else {
#pragma unroll
            for (int j = 0; j < 8; ++j) tmp[j] = 0.f; }
#pragma unroll
        for (int j = 0; j < 8; ++j) { if (k == 1) um1[j] = tmp[j]; else um2[j] = tmp[j]; } }
#pragma unroll 2
    for (int s = 0; s < nT; ++s) { const int t = t0 + s; const size_t ro = (size_t)(rowbase + t) * 1024 + c0;
        const u32x4 xv = *(const u32x4*)(XM + ro), sv = *(const u32x4*)(SA + ro), uv = *(const u32x4*)(U + ro), gv = *(const u32x4*)(G2 + ro);
        float xo[8]; const int to = t - (w - 1);
        if (to >= 0) { const u32x4 v = *(const u32x4*)(XM + (size_t)(rowbase + to) * 1024 + c0);
            xo[0] = bf_lo(v.x); xo[1] = bf_hi(v.x); xo[2] = bf_lo(v.y); xo[3] = bf_hi(v.y); xo[4] = bf_lo(v.z); xo[5] = bf_hi(v.z); xo[6] = bf_lo(v.w); xo[7] = bf_hi(v.w); }
        else if (SAMPLE) { const float* q = BUFM + (size_t)(seq * 15 + 15 + to) * 1024 + c0;
#pragma unroll
            for (int j = 0; j < 8; ++j) xo[j] = q[j]; }
        else {
#pragma unroll
            for (int j = 0; j < 8; ++j) xo[j] = 0.f; }
        const float xc[8] = {bf_lo(xv.x), bf_hi(xv.x), bf_lo(xv.y), bf_hi(xv.y), bf_lo(xv.z), bf_hi(xv.z), bf_lo(xv.w), bf_hi(xv.w)};
        const float sa[8] = {bf_lo(sv.x), bf_hi(sv.x), bf_lo(sv.y), bf_hi(sv.y), bf_lo(sv.z), bf_hi(sv.z), bf_lo(sv.w), bf_hi(sv.w)};
        const float uc[8] = {bf_lo(uv.x), bf_hi(uv.x), bf_lo(uv.y), bf_hi(uv.y), bf_lo(uv.z), bf_hi(uv.z), bf_lo(uv.w), bf_hi(uv.w)};
        const float g2[8] = {bf_lo(gv.x), bf_hi(gv.x), bf_lo(gv.y), bf_hi(gv.y), bf_lo(gv.z), bf_hi(gv.z), bf_lo(gv.w), bf_hi(gv.w)};
        const int cnt = SAMPLE ? w : ((t + 1) < w ? (t + 1) : w);
        const float inv = 1.0f / (float)cnt;
        float ya[8], yb[8];
#pragma unroll
        for (int j = 0; j < 8; ++j) { const float S = sp[j] + xc[j]; ya[j] = (S * inv - xc[j]) * sc[j] * sa[j]; sp[j] = S - xo[j];
            yb[j] = g2[j] * (w0[j] * um2[j] + w1[j] * um1[j] + w2[j] * uc[j]); um2[j] = um1[j]; um1[j] = uc[j]; }
        u32x4 wa, wb;
        wa.x = pk_bf16(ya[0], ya[1]); wa.y = pk_bf16(ya[2], ya[3]); wa.z = pk_bf16(ya[4], ya[5]); wa.w = pk_bf16(ya[6], ya[7]);
        wb.x = pk_bf16(yb[0], yb[1]); wb.y = pk_bf16(yb[2], yb[3]); wb.z = pk_bf16(yb[4], yb[5]); wb.w = pk_bf16(yb[6], yb[7]);
        bf16_t* yo = YC + (size_t)(rowbase + t) * LDP + c0;
        *(u32x4*)yo = wa; *(u32x4*)(yo + 1024) = wb; }
}

__device__ __forceinline__ void phase2(const Params& p) {
    int t_ = threadIdx.x; asm volatile("" : "+v"(t_));
    const int NT = gridDim.x * NTHREADS, gt = blockIdx.x * NTHREADS + t_;
    for (int id = gt; id < 131072; id += NT) { const int cg8 = id & 127, run = id >> 7; stencil_run<false>(p, run >> 8, (run & 255) * 32, 32, cg8 * 8); }
    for (int id = gt; id < 131072; id += NT) { const int cg8 = id & 127, run = id >> 7; stencil_run<true>(p, run >> 5, (run & 31) * 2, 2, cg8 * 8); }
}

template <int NR>
__device__ __forceinline__ void p5_rows(const Params& p, const bf16_t* __restrict__ DL, int r, int nw, int lane) {
    f32x4 v[NR][8]; u32x4 d[NR][4];
#pragma unroll
    for (int k = 0; k < NR; ++k) { const int row = r + k * nw; const float* x = row < TP ? p.xp + (size_t)row * D : p.xs + (size_t)(row - TP) * D;
#pragma unroll
        for (int i = 0; i < 4; ++i) { v[k][2 * i] = *(const f32x4*)(x + (i * 64 + lane) * 8); v[k][2 * i + 1] = *(const f32x4*)(x + (i * 64 + lane) * 8 + 4);
            d[k][i] = *(const u32x4*)(DL + (size_t)row * LDP + (i * 64 + lane) * 8); } }
#pragma unroll
    for (int k = 0; k < NR; ++k) { const int row = r + k * nw; float ss = 0.f;
#pragma unroll
        for (int i = 0; i < 4; ++i) { const u32x4 w = d[k][i];
            v[k][2 * i] += (f32x4){bf_lo(w.x), bf_hi(w.x), bf_lo(w.y), bf_hi(w.y)}; v[k][2 * i + 1] += (f32x4){bf_lo(w.z), bf_hi(w.z), bf_lo(w.w), bf_hi(w.w)}; }
#pragma unroll
        for (int i = 0; i < 8; ++i) ss += (v[k][i][0] * v[k][i][0] + v[k][i][1] * v[k][i][1]) + (v[k][i][2] * v[k][i][2] + v[k][i][3] * v[k][i][3]);
#pragma unroll
        for (int o = 32; o >= 1; o >>= 1) ss += __shfl_xor(ss, o);
        const float rs = rsqrtf(ss * (1.0f / D) + EPS);
        float* y = p.out + O_Y + (size_t)row * D;
#pragma unroll
        for (int i = 0; i < 4; ++i) { const f32x4 g0 = *(const f32x4*)(p.fng + (i * 64 + lane) * 8), g1 = *(const f32x4*)(p.fng + (i * 64 + lane) * 8 + 4);
            *(f32x4*)(y + (i * 64 + lane) * 8) = v[k][2 * i] * rs * g0; *(f32x4*)(y + (i * 64 + lane) * 8 + 4) = v[k][2 * i + 1] * rs * g1; } }
}
__device__ __forceinline__ void phase5(const Params& p) {
    int t_ = threadIdx.x; asm volatile("" : "+v"(t_));
    const int lane = t_ & 63, gw = blockIdx.x * 8 + (t_ >> 6), nw = gridDim.x * 8;
    const bf16_t* DL = (const bf16_t*)(p.ws + WS_H);
    int r = gw;
    for (; r + nw < T; r += 2 * nw) p5_rows<2>(p, DL, r, nw, lane);
    if (r < T) p5_rows<1>(p, DL, r, nw, lane);
}


#define XB_TMO      128
#define XB_XCNT(j)  (256  + 64 * (j))
#define XB_XSUB(j)  (1280 + 64 * (j))
#define XB_XGEN(j)  (2304 + 64 * (j))
#define XB_TOP      3328
#define XB_TOPGEN   3392
#define XCD_BAR_WORDS 3456
#define XB_SPIN_CAP (1u << 18)
__device__ __forceinline__ unsigned xb_ld(unsigned* p)              { return __hip_atomic_load(p, __ATOMIC_RELAXED, __HIP_MEMORY_SCOPE_AGENT); }
__device__ __forceinline__ unsigned xb_add(unsigned* p, unsigned v) { return __hip_atomic_fetch_add(p, v, __ATOMIC_RELAXED, __HIP_MEMORY_SCOPE_AGENT); }
__device__ __forceinline__ unsigned xb_xcc_id() { return (unsigned)__builtin_amdgcn_s_getreg((3 << 11) | 20) & 0xFu; }
#define XB_SPIN(cond, bar) do { unsigned _sp = 0; while (cond) { __builtin_amdgcn_s_sleep(1); \
    if ((++_sp & 255u) == 0u) { if (xb_ld(&(bar)[XB_TMO])) break; if (_sp > XB_SPIN_CAP) { atomicAdd(&(bar)[XB_TMO], 1u); break; } } } } while (0)
struct XcdBarrier { unsigned* bar; unsigned x; volatile LAS unsigned* st; };
__device__ __forceinline__ XcdBarrier xcd_barrier_post(unsigned* bar, volatile LAS unsigned* st) {
    XcdBarrier b; b.bar = bar; b.x = xb_xcc_id(); b.st = st;
    if (threadIdx.x == 0) (void)xb_add(&bar[XB_XCNT(b.x)], 1u);
    return b;
}
__device__ __forceinline__ void xcd_barrier_complete(unsigned* bar, unsigned x, unsigned& nloc, unsigned& nx) {
    const unsigned G = gridDim.x * gridDim.y * gridDim.z;
    unsigned sum, cnt, mine, sp = 0u;
    for (;;) {
        sum = 0u; cnt = 0u; mine = 0u;
#pragma unroll
        for (unsigned j = 0; j < 16; ++j) { const unsigned c = xb_ld(&bar[XB_XCNT(j)]); sum += c; cnt += (c > 0u) ? 1u : 0u; mine = (j == x) ? c : mine; }
        if (sum == G) break;
        __builtin_amdgcn_s_sleep(1);
        if ((++sp & 255u) == 0u) { if (xb_ld(&bar[XB_TMO])) break; if (sp > XB_SPIN_CAP) { atomicAdd(&bar[XB_TMO], 1u); break; } }
    }
    nloc = mine > 0u ? mine : 1u; nx = cnt > 0u ? cnt : 1u;
}
__device__ __forceinline__ void xcd_barrier(const XcdBarrier& b) {
    asm volatile("s_waitcnt vmcnt(0)" ::: "memory");
    __syncthreads();
    if (threadIdx.x == 0) {
        unsigned* bar = b.bar;
        __builtin_amdgcn_s_waitcnt(0);
        unsigned nloc = b.st[0], nx = b.st[1];
        if (nloc == 0u) { xcd_barrier_complete(bar, b.x, nloc, nx); b.st[0] = nloc; b.st[1] = nx; }
        const unsigned old = xb_add(&bar[XB_XSUB(b.x)], 1u);
        const unsigned gen = old / nloc;
        if (old + 1u == (gen + 1u) * nloc) {
            __builtin_amdgcn_fence(__ATOMIC_RELEASE, "agent");
            asm volatile("s_waitcnt vmcnt(0)" ::: "memory");
            const unsigned og = xb_add(&bar[XB_TOP], 1u);
            const unsigned tg = og / nx;
            if (og + 1u == (tg + 1u) * nx) xb_add(&bar[XB_TOPGEN], 1u);
            else XB_SPIN(xb_ld(&bar[XB_TOPGEN]) == tg, bar);
            __builtin_amdgcn_fence(__ATOMIC_ACQUIRE, "agent");
            xb_add(&bar[XB_XGEN(b.x)], 1u);
            asm volatile("s_waitcnt vmcnt(0)" ::: "memory");
        } else {
            XB_SPIN(xb_ld(&bar[XB_XGEN(b.x)]) == gen, bar);
            __builtin_amdgcn_fence(__ATOMIC_ACQUIRE, "agent");
            asm volatile("s_waitcnt vmcnt(0)" ::: "memory");
        }
    }
    __syncthreads();
}

__global__ void __launch_bounds__(NTHREADS, 2) fwd_megakernel(Params p) {
    extern __shared__ __attribute__((aligned(16))) unsigned char lds_raw[];
    LAS unsigned char* lds = (LAS unsigned char*)lds_raw;
    const int G = gridDim.x, c = blockIdx.x;
    volatile LAS unsigned* xst = (volatile LAS unsigned*)(lds + STAGE_BYTES);
    unsigned* barw = (unsigned*)(p.ws + WS_BAR);
    if (threadIdx.x < 2) xst[threadIdx.x] = 0u;
    __syncthreads();
    const XcdBarrier xb = xcd_barrier_post(barw, xst);

    phase_colmax(p, lds);
    xcd_barrier(xb);
    phase0(p, lds);
    xcd_barrier(xb);
    {
        { Epi1 E{(bf16_t*)(p.ws + WS_XM), (bf16_t*)(p.ws + WS_SA), (bf16_t*)(p.ws + WS_U), (bf16_t*)(p.ws + WS_G2), p.out};
          GemmDesc g{(const bf16_t*)(p.ws + WS_H), (const bf16_t*)(p.ws + WS_BIN), LDP, LDP, 32, (const bf16_t*)(p.ws + WS_HG), (const bf16_t*)(p.ws + WS_BIN)}; Sched1a S{G, c}; gemm_phase<0>(lds, g, S, E); }
        { EpiI8 E8{(bf16_t*)(p.ws + WS_SA), (bf16_t*)(p.ws + WS_U), (bf16_t*)(p.ws + WS_G2), (const float*)(p.ws + WS_RSC), (const float*)(p.ws + WS_CSV)};
          GemmDesc g{(const bf16_t*)(p.ws + WS_H8I), (const bf16_t*)(p.ws + WS_BIN8I - (size_t)4 * 256 * LD8), LD8 / 2, LD8 / 2, 16, nullptr, nullptr}; Sched1c S{G, c}; gemm_phase<2>(lds, g, S, E8); }
    }
    xcd_barrier(xb);
    phase2(p);
    {
        GemmDesc g{(const bf16_t*)(p.ws + WS_H8), (const bf16_t*)(p.ws + WS_BIN8 - (size_t)24 * 256 * LD8), LD8 / 2, LD8 / 2, 16, nullptr, nullptr}; Sched1b S{G, c};
        EpiGG EG{(bf16_t*)(p.ws + WS_SGR), (bf16_t*)(p.ws + WS_SGB), p.bgate, 1.0f / W8_SCALE}; gemm_phase<1>(lds, g, S, EG);
    }
    xcd_barrier(xb);
    {
        GemmDesc g{(const bf16_t*)(p.ws + WS_H), (const bf16_t*)(p.ws + WS_BP), LDP, LDP, 16, (const bf16_t*)(p.ws + WS_MG), (const bf16_t*)(p.ws + WS_BO)};
        EpiMix E{EpiD{(const bf16_t*)(p.ws + WS_SGR), (const bf16_t*)(p.ws + WS_SGB), (bf16_t*)(p.ws + WS_MG)}, EpiE{(bf16_t*)(p.ws + WS_H)}};
        { SchedA S{G, c}; gemm_phase<0>(lds, g, S, E); }
        xcd_barrier(xb);
        { SchedB S{G, c}; gemm_phase<0>(lds, g, S, E); }
        xcd_barrier(xb);
        { SchedC S{G, c}; gemm_phase<0>(lds, g, S, E); }
    }
    xcd_barrier(xb);
    phase5(p);
}

extern "C" void kernel_launch(void* const* d_in, const int* in_sizes, int n_in, void* d_out, int out_size, void* d_ws, size_t ws_size, hipStream_t stream) {
    static int grid_blocks = 0;
    if (grid_blocks == 0) {
        if (ws_size < WS_END) { fprintf(stderr, "kernel_launch: workspace too small: %zu < %zu\n", ws_size, (size_t)WS_END); grid_blocks = -1; return; }
        int dev = 0, cus = 0, per_cu = 0;
        hipGetDevice(&dev);
        hipDeviceGetAttribute(&cus, hipDeviceAttributeMultiprocessorCount, dev);
        if (hipFuncSetAttribute((const void*)fwd_megakernel, hipFuncAttributeMaxDynamicSharedMemorySize, LDS_BYTES) != hipSuccess) { fprintf(stderr, "kernel_launch: hipFuncSetAttribute failed\n"); grid_blocks = -1; return; }
        if (hipOccupancyMaxActiveBlocksPerMultiprocessor(&per_cu, (const void*)fwd_megakernel, NTHREADS, LDS_BYTES) != hipSuccess || per_cu < 1) { fprintf(stderr, "kernel_launch: occupancy query failed (%d)\n", per_cu); (void)hipGetLastError(); per_cu = 1; }
        grid_blocks = cus * per_cu;
        if (grid_blocks > 256) grid_blocks = 256;
    }
    if (grid_blocks < 0) return;
    Params p{};
    p.xp = (const float*)d_in[0]; p.xs = (const float*)d_in[1]; p.spool = (const float*)d_in[2]; p.sconv = (const float*)d_in[3]; p.ng = (const float*)d_in[4];
    p.win = (const float*)d_in[5]; p.bgate = (const float*)d_in[6]; p.wmix = (const float*)d_in[7]; p.pscale = (const float*)d_in[8]; p.wconv = (const float*)d_in[9];
    p.wpp = (const float*)d_in[10]; p.wpc = (const float*)d_in[11]; p.wout = (const float*)d_in[12]; p.fng = (const float*)d_in[13];
    p.out = (float*)d_out; p.ws = (unsigned char*)d_ws;
    if (hipMemsetAsync((char*)d_ws + WS_BAR, 0, ZERO_BYTES, stream) != hipSuccess) { fprintf(stderr, "kernel_launch: hipMemsetAsync of the barrier words failed\n"); return; }
    void* args[] = {&p};
    hipError_t e = hipLaunchCooperativeKernel((const void*)fwd_megakernel, dim3(grid_blocks), dim3(NTHREADS), args, LDS_BYTES, stream);
    if (e != hipSuccess) fprintf(stderr, "cooperative launch failed: %s (grid %d)\n", hipGetErrorString(e), grid_blocks);
}
```

```cpp
#include <hip/hip_runtime.h>
#include <hip/hip_cooperative_groups.h>
#include <cstdio>
namespace cg = cooperative_groups;

#define LAS __attribute__((address_space(3)))
typedef unsigned short bf16_t;
typedef short bf16x8 __attribute__((ext_vector_type(8)));
typedef float f32x4 __attribute__((ext_vector_type(4)));
typedef unsigned u32x4 __attribute__((ext_vector_type(4)));
typedef unsigned u32x2 __attribute__((ext_vector_type(2)));
typedef int i32x4 __attribute__((ext_vector_type(4)));
typedef int i32x8 __attribute__((ext_vector_type(8)));

constexpr int D = 2048, TP = 32768, TS = 2048, T = TP + TS;
constexpr int NIN = 10240;
constexpr int LDP = 2048 + 64;
constexpr float EPS = 1e-6f;
constexpr int LD8 = 2048 + 128;
constexpr float W8_SCALE = 64.0f;
constexpr int BM = 256, BK = 64, HALF = 128, HTB = HALF * BK * 2, STAGE_BYTES = 8 * HTB;
constexpr int NTHREADS = 512;
constexpr int LDS_BYTES = STAGE_BYTES + 256;

constexpr size_t O_Y = 0, O_NPP = 71303168, O_NCP = 71364608, O_NPS = 71372800, O_NCS = 71864320;
constexpr size_t WS_H = 0;
constexpr size_t WS_BIN = WS_H + (size_t)T * LDP * 2;
constexpr size_t WS_BP = WS_BIN + (size_t)11264 * LDP * 2;
constexpr size_t WS_BO = WS_BP + (size_t)2048 * LDP * 2;
constexpr size_t WS_XM = WS_BO + (size_t)2048 * LDP * 2;
constexpr size_t WS_SA = WS_XM + (size_t)T * 1024 * 2;
constexpr size_t WS_U = WS_SA + (size_t)T * 1024 * 2;
constexpr size_t WS_G2 = WS_U + (size_t)T * 1024 * 2;
constexpr size_t WS_SGR = WS_G2 + (size_t)T * 1024 * 2;
constexpr size_t WS_SGB = WS_SGR + (size_t)T * 2048 * 2;
constexpr size_t WS_BUFM = WS_SGB + (size_t)T * 2048 * 2;
constexpr size_t WS_SS = WS_BUFM + (size_t)32 * 15 * 1024 * 4;
constexpr size_t WS_BAR = WS_SS + (size_t)T * 32 * 4;
constexpr size_t WS_CMAX = WS_BAR + 16384;
constexpr size_t WS_CMAXW = WS_CMAX + 10240 * 4;
constexpr size_t ZERO_BYTES = 16384 + 10240 * 4 + 1024 * 4;
constexpr size_t WS_H8 = WS_CMAXW + 1024 * 4;
constexpr size_t WS_BIN8 = WS_H8 + (size_t)T * LD8;
constexpr size_t WS_H8I = WS_BIN8 + (size_t)4096 * LD8;
constexpr size_t WS_BIN8I = WS_H8I + (size_t)T * LD8;
constexpr size_t WS_CSV = WS_BIN8I + (size_t)6144 * LD8;
constexpr size_t WS_RSC = WS_CSV + 6144 * 4;
constexpr size_t WS_HG = WS_RSC + (size_t)T * 4;
constexpr size_t WS_END = WS_HG + (size_t)256 * LDP * 2;
constexpr size_t WS_MG = WS_XM;

struct Params {
    const float *xp, *xs, *spool, *sconv, *ng, *win, *bgate, *wmix, *pscale, *wconv, *wpp, *wpc, *wout, *fng;
    float* out; unsigned char* ws;
};

typedef float f32x2_t __attribute__((ext_vector_type(2)));
typedef __bf16 bf16x2_t __attribute__((ext_vector_type(2)));
__device__ __forceinline__ unsigned pk_bf16(float lo, float hi) { const f32x2_t v = {lo, hi}; return __builtin_bit_cast(unsigned, __builtin_convertvector(v, bf16x2_t)); }
__device__ __forceinline__ unsigned pk_fp8x4(float a, float b, float c, float d) { int w = 0; w = __builtin_amdgcn_cvt_pk_fp8_f32(a, b, w, false); w = __builtin_amdgcn_cvt_pk_fp8_f32(c, d, w, true); return (unsigned)w; }
__device__ __forceinline__ unsigned pk_i8x4(float a, float b, float c, float d) {
    const int q0 = (int)rintf(a), q1 = (int)rintf(b), q2 = (int)rintf(c), q3 = (int)rintf(d);
    return (unsigned)(q0 & 255) | ((unsigned)(q1 & 255) << 8) | ((unsigned)(q2 & 255) << 16) | ((unsigned)q3 << 24); }
__device__ __forceinline__ float bf_lo(unsigned w) { return __uint_as_float(w << 16); }
__device__ __forceinline__ float bf_hi(unsigned w) { return __uint_as_float(w & 0xffff0000u); }
__device__ __forceinline__ float sigmoid_f(float x) { x = fminf(fmaxf(x, -40.f), 40.f); return __builtin_amdgcn_rcpf(1.0f + __builtin_amdgcn_exp2f(-1.44269504f * x)); }
__device__ __forceinline__ float silu_f(float x) { return x * sigmoid_f(x); }

__device__ __forceinline__ int lds_byte(int r, int c) { const int st = (r >> 4) * 2 + (c >> 5), rr = r & 15, cc = c & 31, ob = rr * 64 + cc * 2; return st * 1024 + (ob ^ (((ob >> 9) & 1) << 5)); }
__device__ __forceinline__ void stage_rc(int b, int& R, int& C) { const int st = b / 1024, sb = b % 1024, swz = sb ^ (((sb >> 9) & 1) << 5); R = (st >> 1) * 16 + swz / 64; C = (st & 1) * 32 + (swz % 64) / 2; }
__device__ __forceinline__ int perm32(int rho) { const int n = rho >> 4, i = rho & 15; return 8 * (i >> 2) + 4 * n + (i & 3); }

struct Unit { int pm, pn, kh, type; };
struct GemmDesc { const bf16_t* A; const bf16_t* Bt; int lda, ldb, nt; const bf16_t* A2; const bf16_t* Bt2; };

__device__ __forceinline__ void tile_map(int L, int nM, int nN, int& pm, int& pn) {
    const int nwg = nM * nN; int wgid = L;
    { const int q = nwg / 8, r = nwg % 8, xcd = wgid % 8, off = wgid / 8; wgid = (xcd < r ? xcd * (q + 1) : r * (q + 1) + (xcd - r) * q) + off; }
    const int nig = 8 * nN, gid = wgid / nig, fm = gid * 8, gsz = (nM - fm) < 8 ? (nM - fm) : 8;
    pm = fm + ((wgid % nig) % gsz); pn = (wgid % nig) / gsz;
}

template <int MODE  , class Epi, class Sched>
__device__ __forceinline__ void gemm_phase(LAS unsigned char* lds, const GemmDesc g, const Sched& S, const Epi& E) {
    int tid_ = threadIdx.x; asm volatile("" : "+v"(tid_));
    const int tid = tid_, wid = __builtin_amdgcn_readfirstlane(tid >> 6), lane = tid & 63, wr = wid >> 2, wc = wid & 3, fr = lane & 15, fq = lane >> 4;
    const int nt = g.nt;
    unsigned voffA[2], voffB[2];
#pragma unroll
    for (int i = 0; i < 2; ++i) { int R, C; stage_rc(tid * 16 + i * 8192, R, C); const int Rb = (R & ~31) + perm32(R & 31);
        voffA[i] = (unsigned)(R * g.lda + C) * 2u; voffB[i] = (unsigned)(Rb * g.ldb + C) * 2u; }
    const size_t kstep = (size_t)(BK * 2);
    const size_t hstepA = (size_t)HALF * g.lda * 2, hstepB = (size_t)HALF * g.ldb * 2;
    const size_t khb = (size_t)nt * kstep;
    const unsigned ldsw = (unsigned)wid * 1024u;
    const int aoff = lds_byte(wr * 64 + fr, fq * 8), boff = lds_byte(wc * 32 + fr, fq * 8);
#define G_SA(b, h) (((b) * 2 + (h)) * HTB)
#define G_SB(b, h) ((4 + (b) * 2 + (h)) * HTB)
#define G_STAGE(bufoff, gbase, voff) do { _Pragma("unroll") for (int _i = 0; _i < 2; ++_i) \
        __builtin_amdgcn_global_load_lds((const unsigned*)((const char*)(gbase) + (voff)[_i]), (LAS unsigned*)(lds + (bufoff) + ldsw + _i * 8192), 16, 0, 0); } while (0)
#define G_LDA(dst, b, h) do { if constexpr (MODE == 1) { _Pragma("unroll") for (int m = 0; m < 4; ++m) { dst##8[m].lo = *(const LAS i32x4*)(lds + G_SA(b, h) + aoff + m * 2048); dst##8[m].hi = *(const LAS i32x4*)(lds + G_SA(b, h) + aoff + m * 2048 + 1024); } } \
        else { _Pragma("unroll") for (int m = 0; m < 4; ++m) _Pragma("unroll") for (int k = 0; k < 2; ++k) dst[m][k] = *(const LAS bf16x8*)(lds + G_SA(b, h) + aoff + m * 2048 + k * 1024); } } while (0)
#define G_LDB(dst, b, h) do { if constexpr (MODE == 1) { _Pragma("unroll") for (int n = 0; n < 2; ++n) { dst##8[n].lo = *(const LAS i32x4*)(lds + G_SB(b, h) + boff + n * 2048); dst##8[n].hi = *(const LAS i32x4*)(lds + G_SB(b, h) + boff + n * 2048 + 1024); } } \
        else { _Pragma("unroll") for (int n = 0; n < 2; ++n) _Pragma("unroll") for (int k = 0; k < 2; ++k) dst[n][k] = *(const LAS bf16x8*)(lds + G_SB(b, h) + boff + n * 2048 + k * 1024); } } while (0)
#define G_MMA(ai, bj, At, Bt) do { __builtin_amdgcn_s_setprio(1); \
        if constexpr (MODE == 1) { _Pragma("unroll") for (int m = 0; m < 4; ++m) _Pragma("unroll") for (int n = 0; n < 2; ++n) \
            asm volatile("v_mfma_scale_f32_16x16x128_f8f6f4 %0, %1, %2, %0, %3, %3 op_sel_hi:[0,0,0]" : "+v"(acc[ai][bj][m][n]) : "v"(Bt##8[n]), "v"(At##8[m]), "v"(one_scale)); } \
        else { _Pragma("unroll") for (int m = 0; m < 4; ++m) _Pragma("unroll") for (int n = 0; n < 2; ++n) _Pragma("unroll") for (int k = 0; k < 2; ++k) \
            { if constexpr (MODE == 2) acc[ai][bj][m][n] = __builtin_bit_cast(f32x4, __builtin_amdgcn_mfma_i32_16x16x64_i8(__builtin_bit_cast(i32x4, Bt[n][k]), __builtin_bit_cast(i32x4, At[m][k]), __builtin_bit_cast(i32x4, acc[ai][bj][m][n]), 0, 0, 0)); \
              else acc[ai][bj][m][n] = __builtin_amdgcn_mfma_f32_16x16x32_bf16(Bt[n][k], At[m][k], acc[ai][bj][m][n], 0, 0, 0); } } \
        __builtin_amdgcn_s_setprio(0); } while (0)
#define G_WAIT_V(n) asm volatile("s_waitcnt vmcnt(" #n ")" ::: "memory")
#define G_WAIT_L(n) asm volatile("s_waitcnt lgkmcnt(" #n ")" ::: "memory")
#define G_BAR __builtin_amdgcn_s_barrier()
#define G_SCHED __builtin_amdgcn_sched_barrier(0)
    Unit cur, nxt; int ui = 0;
    if (!S.next(0, cur)) return;
    f32x4 acc[2][2][4][2];
#pragma unroll
    for (int a = 0; a < 2; ++a)
#pragma unroll
        for (int b = 0; b < 2; ++b)
#pragma unroll
            for (int m = 0; m < 4; ++m)
#pragma unroll
                for (int n = 0; n < 2; ++n) acc[a][b][m][n] = (f32x4){0.f, 0.f, 0.f, 0.f};
    bf16x8 At[4][2], B0[2][2], B1[2][2];
    const int one_scale = 0x7f7f7f7f;
    i32x8 At8[4], B08[2], B18[2];
    const char* cA = (const char*)(cur.type ? g.A2 : g.A) + (size_t)cur.pm * 2 * hstepA + (size_t)cur.kh * khb;
    const char* cB = (const char*)(cur.type ? g.Bt2 : g.Bt) + (size_t)cur.pn * 2 * hstepB + (size_t)cur.kh * khb;
    G_STAGE(G_SB(0, 0), cB, voffB); G_STAGE(G_SA(0, 0), cA, voffA); G_STAGE(G_SB(0, 1), cB + hstepB, voffB); G_STAGE(G_SA(0, 1), cA + hstepA, voffA);
    if (wr == 1) G_BAR;
    G_WAIT_V(4); G_BAR;
    G_STAGE(G_SB(1, 0), cB + kstep, voffB); G_STAGE(G_SA(1, 0), cA + kstep, voffA); G_STAGE(G_SB(1, 1), cB + hstepB + kstep, voffB);
    G_WAIT_V(6); G_BAR;
    for (;;) {
        const bool has_next = S.next(ui + 1, nxt);
        const char* nA = has_next ? (const char*)(nxt.type ? g.A2 : g.A) + (size_t)nxt.pm * 2 * hstepA + (size_t)nxt.kh * khb : cA;
        const char* nB = has_next ? (const char*)(nxt.type ? g.Bt2 : g.Bt) + (size_t)nxt.pn * 2 * hstepB + (size_t)nxt.kh * khb : cB;
        for (int t = 0; t < nt; t += 2) {
            const bool last = (t == nt - 2);
            const char* a1 = cA + (size_t)(t + 1) * kstep;
            const char* a2 = last ? nA : cA + (size_t)(t + 2) * kstep; const char* b2 = last ? nB : cB + (size_t)(t + 2) * kstep;
            const char* a3 = a2 + kstep; const char* b3 = b2 + kstep;
            G_LDB(B0, 0, 0); G_SCHED; G_LDA(At, 0, 0); G_STAGE(G_SA(1, 1), a1 + hstepA, voffA);
            G_WAIT_L(8); G_BAR; G_WAIT_L(0); G_MMA(0, 0, At, B0); G_BAR; G_SCHED;
            G_LDB(B1, 0, 1); G_STAGE(G_SB(0, 0), b2, voffB);
            G_BAR; G_WAIT_L(0); G_MMA(0, 1, At, B1); G_BAR;
            G_LDA(At, 0, 1); G_STAGE(G_SA(0, 0), a2, voffA);
            G_BAR; G_WAIT_L(0); G_MMA(1, 0, At, B0); G_BAR; G_SCHED;
            G_STAGE(G_SB(0, 1), b2 + hstepB, voffB);
            G_WAIT_V(6); G_BAR; G_MMA(1, 1, At, B1); G_BAR;
            G_LDB(B0, 1, 0); G_SCHED; G_LDA(At, 1, 0); G_STAGE(G_SA(0, 1), a2 + hstepA, voffA);
            G_WAIT_L(8); G_BAR; G_WAIT_L(0); G_MMA(0, 0, At, B0); G_BAR; G_SCHED;
            G_LDB(B1, 1, 1); G_STAGE(G_SB(1, 0), b3, voffB);
            G_BAR; G_WAIT_L(0); G_MMA(0, 1, At, B1); G_BAR;
            G_LDA(At, 1, 1); G_STAGE(G_SA(1, 0), a3, voffA);
            G_BAR; G_WAIT_L(0); G_MMA(1, 0, At, B0); G_BAR; G_SCHED;
            G_STAGE(G_SB(1, 1), b3 + hstepB, voffB);
            G_WAIT_V(6); G_BAR; G_MMA(1, 1, At, B1); G_BAR;
        }
        if constexpr (MODE == 1) asm volatile("s_nop 15\n\ts_nop 15" ::: "memory");
        const bool zero = E(acc, cur, wr, wc, fr, fq);
        if (!has_next) break;
        if (zero) {
#pragma unroll
            for (int a = 0; a < 2; ++a)
#pragma unroll
                for (int b = 0; b < 2; ++b)
#pragma unroll
                    for (int m = 0; m < 4; ++m)
#pragma unroll
                        for (int n = 0; n < 2; ++n) acc[a][b][m][n] = (f32x4){0.f, 0.f, 0.f, 0.f};
        }
        cur = nxt; cA = nA; cB = nB; ++ui;
    }
    G_WAIT_V(0);
    if (wr == 0) G_BAR;
    G_BAR;
#undef G_SA
#undef G_SB
#undef G_STAGE
#undef G_LDA
#undef G_LDB
#undef G_MMA
#undef G_WAIT_V
#undef G_WAIT_L
#undef G_BAR
#undef G_SCHED
}

struct Sched1a {
    int G, c;
    __device__ __forceinline__ bool next(int i, Unit& u) const {
        int L = i * G + c; u.kh = 0; u.type = 0;
        if (L < 48) { const int e = L >> 2; u.pm = e < 4 ? e * 32 + 31 : 124 + e; u.pn = 40 + (L & 3); return true; }
        L -= 48; if (L >= 8) return false;
        u.pm = 0; u.pn = 8 + L; u.type = 1; return true;
    }
};
struct Sched1c {
    int G, c;
    __device__ __forceinline__ bool next(int i, Unit& u) const { const int L = i * G + (G - 1 - c); if (L >= 3264) return false; tile_map(L, 136, 24, u.pm, u.pn); u.pn += 4;     u.kh = 0; u.type = 0; return true; }
};
struct Sched1b {
    int G, c;
    __device__ __forceinline__ bool next(int i, Unit& u) const { const int L = i * G + (G - 1 - c); if (L >= 2176) return false; tile_map(L, 136, 16, u.pm, u.pn); u.pn += 24; u.kh = 0; u.type = 0; return true; }
};
struct SchedA {
    int G, c;
    __device__ __forceinline__ bool next(int i, Unit& u) const { const int L = (i >> 1) * G + c; if (L >= 1024) return false; tile_map(L, 128, 8, u.pm, u.pn); u.kh = i & 1; u.type = 0; return true; }
};
struct SchedB {
    int G, c;
    __device__ __forceinline__ bool next(int i, Unit& u) const { const int L = (i >> 1) * G + c; if (L >= 1024) return false; u.kh = i & 1;
        if (L < 960) { tile_map(L, 120, 8, u.pm, u.pn); u.type = 1; } else { tile_map(L - 960, 8, 8, u.pm, u.pn); u.pm += 128; u.type = 0; }
        return true; }
};
struct SchedC {
    int G, c;
    __device__ __forceinline__ bool next(int i, Unit& u) const { const int L = (i >> 1) * G + c; if (L >= 128) return false; tile_map(L, 16, 8, u.pm, u.pn); u.pm += 120; u.kh = i & 1; u.type = 1; return true; }
};

struct Epi1 {
    bf16_t *XM, *SA, *U, *G2; float* out;
    __device__ __forceinline__ bool operator()(f32x4 (&acc)[2][2][4][2], const Unit& u, int wr, int wc, int fr, int fq) const {
        const int pn = u.pn, r0 = u.pm * BM + wr * 64 + fr, cl = wc * 32 + fq * 8;
        if (pn < 8) {
            bf16_t* O = pn < 4 ? XM : SA; const bool act = pn >= 4; const int c0 = (pn & 3) * 256 + cl;
#pragma unroll
            for (int ai = 0; ai < 2; ++ai)
#pragma unroll
                for (int m = 0; m < 4; ++m) { bf16_t* rowp = O + (size_t)(r0 + ai * HALF + m * 16) * 1024 + c0;
#pragma unroll
                    for (int bj = 0; bj < 2; ++bj) { f32x4 v0 = acc[ai][bj][m][0], v1 = acc[ai][bj][m][1];
                        if (act) {
#pragma unroll
                            for (int j = 0; j < 4; ++j) { v0[j] = silu_f(v0[j]); v1[j] = silu_f(v1[j]); } }
                        u32x4 w; w.x = pk_bf16(v0[0], v0[1]); w.y = pk_bf16(v0[2], v0[3]); w.z = pk_bf16(v1[0], v1[1]); w.w = pk_bf16(v1[2], v1[3]);
                        *(u32x4*)(rowp + bj * HALF) = w; } }
        } else if (pn < 24) {
            const bool isvc = pn < 16; bf16_t* O = isvc ? U : G2; const int ch0 = ((pn - 8) & 7) * 128 + cl;
#pragma unroll
            for (int ai = 0; ai < 2; ++ai)
#pragma unroll
                for (int m = 0; m < 4; ++m) { const int row = r0 + ai * HALF + m * 16;
                    f32x4 v0, v1; const f32x4 a0 = acc[ai][0][m][0], a1 = acc[ai][0][m][1], b0 = acc[ai][1][m][0], b1 = acc[ai][1][m][1];
                    if (isvc) { v0 = a0 * b0; v1 = a1 * b1; }
                    else {
#pragma unroll
                        for (int j = 0; j < 4; ++j) { v0[j] = a0[j] * silu_f(b0[j]); v1[j] = a1[j] * silu_f(b1[j]); } }
                    u32x4 w; w.x = pk_bf16(v0[0], v0[1]); w.y = pk_bf16(v0[2], v0[3]); w.z = pk_bf16(v1[0], v1[1]); w.w = pk_bf16(v1[2], v1[3]);
                    if (u.type == 1) {
                        if (row < 72) { float* dst = (row < 8 ? out + O_NCP + (size_t)row * 1024 : out + O_NCS + (size_t)(row - 8) * 1024) + ch0; *(f32x4*)dst = v0; *(f32x4*)(dst + 4) = v1; } }
                    else *(u32x4*)(O + (size_t)row * 1024 + ch0) = w; }
        } else {
            const bool samp = u.pm >= 128; const int c0 = (pn - 40) * 256 + cl;
            if (fr >= 1) {
#pragma unroll
                for (int ai = 0; ai < 2; ++ai) {
                    if (samp || (ai == 1 && wr == 1)) { const int row = r0 + ai * HALF + 48;
                        float* dst = samp ? out + O_NPS + ((size_t)((row - TP) >> 6) * 15 + (fr - 1)) * 1024 + c0 : out + O_NPP + ((size_t)(row >> 13) * 15 + (fr - 1)) * 1024 + c0;
#pragma unroll
                        for (int bj = 0; bj < 2; ++bj) { *(f32x4*)(dst + bj * HALF) = acc[ai][bj][3][0]; *(f32x4*)(dst + bj * HALF + 4) = acc[ai][bj][3][1]; } } }
            }
        }
        return true;
    }
};

struct EpiI8 {
    bf16_t *SA, *U, *G2; const float* rsc; const float* csv;
    __device__ __forceinline__ bool operator()(f32x4 (&acc)[2][2][4][2], const Unit& u, int wr, int wc, int fr, int fq) const {
        const int pn = u.pn, r0 = u.pm * BM + wr * 64 + fr, cl = wc * 32 + fq * 8;
        const float* cq = csv + (pn - 4) * 256 + cl;
        const f32x4 c00 = *(const f32x4*)(cq), c01 = *(const f32x4*)(cq + 4), c10 = *(const f32x4*)(cq + HALF), c11 = *(const f32x4*)(cq + HALF + 4);
        const int kind = pn < 8 ? 0 : (pn < 16 ? 1 : (pn < 24 ? 2 : 3));
        bf16_t* O = SA + (ptrdiff_t)(kind == 3 ? -1 : kind) * ((ptrdiff_t)T * 1024);
        const int c0 = (kind == 0 || kind == 3) ? (pn & 3) * 256 + cl : ((pn - 8) & 7) * 128 + cl;
#pragma unroll
        for (int ai = 0; ai < 2; ++ai)
#pragma unroll
            for (int m = 0; m < 4; ++m) { const int row = r0 + ai * HALF + m * 16; const float rq = rsc[row];
                const i32x4 i00 = __builtin_bit_cast(i32x4, acc[ai][0][m][0]), i01 = __builtin_bit_cast(i32x4, acc[ai][0][m][1]), i10 = __builtin_bit_cast(i32x4, acc[ai][1][m][0]), i11 = __builtin_bit_cast(i32x4, acc[ai][1][m][1]);
                f32x4 a0, a1, b0, b1;
#pragma unroll
                for (int j = 0; j < 4; ++j) { a0[j] = (float)i00[j] * (rq * c00[j]); a1[j] = (float)i01[j] * (rq * c01[j]); b0[j] = (float)i10[j] * (rq * c10[j]); b1[j] = (float)i11[j] * (rq * c11[j]); }
                if (kind == 0 || kind == 3) {
                    if (kind == 0) {
#pragma unroll
                        for (int j = 0; j < 4; ++j) { a0[j] = silu_f(a0[j]); a1[j] = silu_f(a1[j]); b0[j] = silu_f(b0[j]); b1[j] = silu_f(b1[j]); } }
                    u32x4 w; w.x = pk_bf16(a0[0], a0[1]); w.y = pk_bf16(a0[2], a0[3]); w.z = pk_bf16(a1[0], a1[1]); w.w = pk_bf16(a1[2], a1[3]);
                    *(u32x4*)(O + (size_t)row * 1024 + c0) = w;
                    w.x = pk_bf16(b0[0], b0[1]); w.y = pk_bf16(b0[2], b0[3]); w.z = pk_bf16(b1[0], b1[1]); w.w = pk_bf16(b1[2], b1[3]);
                    *(u32x4*)(O + (size_t)row * 1024 + c0 + HALF) = w;
                } else { f32x4 v0, v1;
                    if (kind == 1) { v0 = a0 * b0; v1 = a1 * b1; }
                    else {
#pragma unroll
                        for (int j = 0; j < 4; ++j) { v0[j] = a0[j] * silu_f(b0[j]); v1[j] = a1[j] * silu_f(b1[j]); } }
                    u32x4 w; w.x = pk_bf16(v0[0], v0[1]); w.y = pk_bf16(v0[2], v0[3]); w.z = pk_bf16(v1[0], v1[1]); w.w = pk_bf16(v1[2], v1[3]);
                    *(u32x4*)(O + (size_t)row * 1024 + c0) = w; } }
        return true;
    }
};
struct EpiGG {
    bf16_t *SGR, *SGB; const float* bgate; float gsc;
    __device__ __forceinline__ bool operator()(f32x4 (&acc)[2][2][4][2], const Unit& u, int wr, int wc, int fr, int fq) const {
        const int pn = u.pn, r0 = u.pm * BM + wr * 64 + fr, cl = wc * 32 + fq * 8;
        {
            const int ch0 = (pn - 24) * 128 + cl;
            const f32x4 ba0 = *(const f32x4*)(bgate + ch0), ba1 = *(const f32x4*)(bgate + ch0 + 4), bb0 = *(const f32x4*)(bgate + D + ch0), bb1 = *(const f32x4*)(bgate + D + ch0 + 4);
#pragma unroll
            for (int ai = 0; ai < 2; ++ai)
#pragma unroll
                for (int m = 0; m < 4; ++m) { const int row = r0 + ai * HALF + m * 16;
                    const f32x4 a0 = acc[ai][0][m][0] * gsc + ba0, a1 = acc[ai][0][m][1] * gsc + ba1, b0 = acc[ai][1][m][0] * gsc + bb0, b1 = acc[ai][1][m][1] * gsc + bb1;
                    f32x4 r0v, r1v, s0v, s1v;
#pragma unroll
                    for (int j = 0; j < 4; ++j) {
                        const float ea0 = __builtin_amdgcn_exp2f(-1.44269504f * fminf(fmaxf(a0[j], -40.f), 40.f)), eb0 = __builtin_amdgcn_exp2f(-1.44269504f * fminf(fmaxf(b0[j], -40.f), 40.f));
                        const float ea1 = __builtin_amdgcn_exp2f(-1.44269504f * fminf(fmaxf(a1[j], -40.f), 40.f)), eb1 = __builtin_amdgcn_exp2f(-1.44269504f * fminf(fmaxf(b1[j], -40.f), 40.f));
                        s0v[j] = __builtin_amdgcn_rcpf(1.0f + eb0); s1v[j] = __builtin_amdgcn_rcpf(1.0f + eb1);
                        r0v[j] = (1.0f + eb0) * __builtin_amdgcn_rcpf(1.0f + ea0); r1v[j] = (1.0f + eb1) * __builtin_amdgcn_rcpf(1.0f + ea1); }
                    u32x4 w; w.x = pk_bf16(r0v[0], r0v[1]); w.y = pk_bf16(r0v[2], r0v[3]); w.z = pk_bf16(r1v[0], r1v[1]); w.w = pk_bf16(r1v[2], r1v[3]);
                    *(u32x4*)(SGR + (size_t)row * D + ch0) = w;
                    w.x = pk_bf16(s0v[0], s0v[1]); w.y = pk_bf16(s0v[2], s0v[3]); w.z = pk_bf16(s1v[0], s1v[1]); w.w = pk_bf16(s1v[2], s1v[3]);
                    *(u32x4*)(SGB + (size_t)row * D + ch0) = w; }
        }
        return true;
    }
};

struct EpiD {
    const bf16_t *SGR, *SGB; bf16_t* MG;
    __device__ __forceinline__ bool operator()(f32x4 (&acc)[2][2][4][2], const Unit& u, int wr, int wc, int fr, int fq) const {
        const int r0 = u.pm * BM + wr * 64 + fr, c0 = u.pn * BM + wc * 32 + fq * 8;
        const bf16_t* S = u.kh ? SGB : SGR;
#pragma unroll
        for (int ai = 0; ai < 2; ++ai)
#pragma unroll
            for (int m = 0; m < 4; ++m) { const size_t off = (size_t)(r0 + ai * HALF + m * 16) * D + c0;
#pragma unroll
                for (int bj = 0; bj < 2; ++bj) { const u32x4 s = *(const u32x4*)(S + off + bj * HALF);
                    f32x4 v0 = acc[ai][bj][m][0], v1 = acc[ai][bj][m][1];
                    v0[0] *= bf_lo(s.x); v0[1] *= bf_hi(s.x); v0[2] *= bf_lo(s.y); v0[3] *= bf_hi(s.y);
                    v1[0] *= bf_lo(s.z); v1[1] *= bf_hi(s.z); v1[2] *= bf_lo(s.w); v1[3] *= bf_hi(s.w);
                    acc[ai][bj][m][0] = v0; acc[ai][bj][m][1] = v1; } }
        if (u.kh == 0) return false;
#pragma unroll
        for (int ai = 0; ai < 2; ++ai)
#pragma unroll
            for (int m = 0; m < 4; ++m) { const size_t off = (size_t)(r0 + ai * HALF + m * 16) * LDP + c0;
#pragma unroll
                for (int bj = 0; bj < 2; ++bj) { const f32x4 v0 = acc[ai][bj][m][0], v1 = acc[ai][bj][m][1];
                    u32x4 w; w.x = pk_bf16(v0[0], v0[1]); w.y = pk_bf16(v0[2], v0[3]); w.z = pk_bf16(v1[0], v1[1]); w.w = pk_bf16(v1[2], v1[3]);
                    *(u32x4*)(MG + off + bj * HALF) = w; } }
        return true;
    }
};

struct EpiE {
    bf16_t* DL;
    __device__ __forceinline__ bool operator()(f32x4 (&acc)[2][2][4][2], const Unit& u, int wr, int wc, int fr, int fq) const {
        const int r0 = u.pm * BM + wr * 64 + fr, c0 = u.pn * BM + wc * 32 + fq * 8;
#pragma unroll
        for (int ai = 0; ai < 2; ++ai)
#pragma unroll
            for (int m = 0; m < 4; ++m) { bf16_t* rowp = DL + (size_t)(r0 + ai * HALF + m * 16) * LDP + c0;
#pragma unroll
                for (int bj = 0; bj < 2; ++bj) { const f32x4 v0 = acc[ai][bj][m][0], v1 = acc[ai][bj][m][1];
                    u32x4 w; w.x = pk_bf16(v0[0], v0[1]); w.y = pk_bf16(v0[2], v0[3]); w.z = pk_bf16(v1[0], v1[1]); w.w = pk_bf16(v1[2], v1[3]);
                    *(u32x4*)(rowp + bj * HALF) = w; } }
        return true;
    }
};

struct EpiMix {
    EpiD d; EpiE e;
    __device__ __forceinline__ bool operator()(f32x4 (&acc)[2][2][4][2], const Unit& u, int wr, int wc, int fr, int fq) const {
        if (u.type == 0) return d(acc, u, wr, wc, fr, fq);
        if (u.kh == 0) return false;
        return e(acc, u, wr, wc, fr, fq);
    }
};

struct TrJob { const float* src; bf16_t* dst; int sld; unsigned char* dst8; unsigned char* dst8i; const float* cm; float* csv; int wr16; };
__device__ __forceinline__ int win_srccol(int vch) {
    const int pn = vch >> 2, q = vch & 3, bj = q >> 1, cl0 = (q & 1) * 64;
    if (pn < 8) return 1024 + 256 * (pn - 4) + q * 64;
    if (pn < 16) return (bj ? 4096 : 2048) + 128 * (pn - 8) + cl0;
    if (pn < 24) return (bj ? 5120 : 3072) + 128 * (pn - 16) + cl0;
    if (pn < 40) return (bj ? 8192 : 6144) + 128 * (pn - 24) + cl0;
    return 256 * (pn - 40) + q * 64;
}
__device__ __forceinline__ TrJob tr_job(const Params& p, int j) {
    TrJob t;
    t.dst8 = nullptr; t.dst8i = nullptr; t.cm = nullptr; t.csv = nullptr; t.wr16 = 1;
    if (j < 5120) { const int vch = 16 + (j >> 5), kc = j & 31; t.src = p.win + (size_t)(kc * 64) * NIN + win_srccol(vch); t.sld = NIN; t.dst = (bf16_t*)(p.ws + WS_BIN) + (size_t)(vch * 64) * LDP + kc * 64;
        if (vch >= 96 && vch < 160) { t.dst8 = p.ws + WS_BIN8 + (size_t)((vch - 96) * 64) * LD8 + kc * 64; t.wr16 = 0; }
        if (vch < 96) { t.dst8i = p.ws + WS_BIN8I + (size_t)((vch - 16) * 64) * LD8 + kc * 64; t.cm = (const float*)(p.ws + WS_CMAX) + win_srccol(vch);
            if (kc == 0) t.csv = (float*)(p.ws + WS_CSV) + (vch - 16) * 64;
            t.wr16 = (vch >= 32 && vch < 64) ? 1 : 0; } }
    else if (j < 6144) { const int jj = j - 5120, nc = jj >> 5, kc = jj & 31;
        t.src = (kc < 16 ? p.wpp + (size_t)(kc * 64) * D : p.wpc + (size_t)((kc - 16) * 64) * D) + nc * 64; t.sld = D; t.dst = (bf16_t*)(p.ws + WS_BP) + (size_t)(nc * 64) * LDP + kc * 64; }
    else { const int jj = j - 6144, nc = jj >> 5, kc = jj & 31; t.src = p.wout + (size_t)(kc * 64) * D + nc * 64; t.sld = D; t.dst = (bf16_t*)(p.ws + WS_BO) + (size_t)(nc * 64) * LDP + kc * 64; }
    return t;
}
__device__ __forceinline__ void tr_load4(const Params& p, int j0, int tid, f32x4 (&v)[4][2]) {
#pragma unroll
    for (int q = 0; q < 4; ++q) { const TrJob t = tr_job(p, j0 + q);
#pragma unroll
        for (int i = 0; i < 2; ++i) { const int idx = tid + i * 512, kr = idx >> 4, c4 = idx & 15; v[q][i] = *(const f32x4*)(t.src + (size_t)kr * t.sld + c4 * 4); } }
}
__device__ __forceinline__ void tr_all(const Params& p, LAS float* sm, int b, int G, int tid) {
    f32x4 v[4][2];
    int jb = b;
    if (jb < 1792) tr_load4(p, jb * 4, tid, v);
    while (jb < 1792) {
#pragma unroll
        for (int q = 0; q < 4; ++q)
#pragma unroll
            for (int i = 0; i < 2; ++i) { const int idx = tid + i * 512, kr = idx >> 4, c4 = idx & 15; LAS float* d = sm + q * 4160 + kr * 65 + c4 * 4; d[0] = v[q][i][0]; d[1] = v[q][i][1]; d[2] = v[q][i][2]; d[3] = v[q][i][3]; }
        __syncthreads();
        const int nb = jb + G;
        if (nb < 1792) tr_load4(p, nb * 4, tid, v);
        const int kg = tid & 7, c = tid >> 3;
#pragma unroll 1
        for (int q = 0; q < 4; ++q) { const TrJob t = tr_job(p, jb * 4 + q);
            float f[8];
#pragma unroll
            for (int i = 0; i < 8; ++i) f[i] = sm[q * 4160 + (kg * 8 + i) * 65 + c];
            if (t.dst8) { u32x2 w8; w8.x = pk_fp8x4(f[0] * W8_SCALE, f[1] * W8_SCALE, f[2] * W8_SCALE, f[3] * W8_SCALE); w8.y = pk_fp8x4(f[4] * W8_SCALE, f[5] * W8_SCALE, f[6] * W8_SCALE, f[7] * W8_SCALE);
                *(u32x2*)(t.dst8 + (size_t)c * LD8 + kg * 8) = w8; }
            if (t.dst8i) { const float cmx = t.cm[c], sc = cmx > 0.f ? 127.0f / cmx : 0.f;
                u32x2 w8; w8.x = pk_i8x4(f[0] * sc, f[1] * sc, f[2] * sc, f[3] * sc); w8.y = pk_i8x4(f[4] * sc, f[5] * sc, f[6] * sc, f[7] * sc);
                *(u32x2*)(t.dst8i + (size_t)c * LD8 + kg * 8) = w8;
                if (t.csv && kg == 0) t.csv[c] = cmx * (1.0f / 127.0f); }
            if (t.wr16) { u32x4 w; w.x = pk_bf16(f[0], f[1]); w.y = pk_bf16(f[2], f[3]); w.z = pk_bf16(f[4], f[5]); w.w = pk_bf16(f[6], f[7]);
                *(u32x4*)(t.dst + (size_t)c * LDP + kg * 8) = w; } }
        __syncthreads();
        jb = nb;
    }
}

template <bool TRANS>
__device__ __forceinline__ void mm_tile(LAS float* sm, int tid, const float* __restrict__ A, int lda, int r0, int rmax, int acol0, const float* __restrict__ Wm, int d0, void* dstv, int ldd, int n0, unsigned* cmaxw) {
    LAS float* As = sm; LAS float* Bt = sm + 64 * 68;
    const int lane = tid & 63, w = tid >> 6, fr = lane & 15, fq = lane >> 4, br = w >> 1, bc0 = (w & 1) * 2;
    f32x4 acc0 = (f32x4){0.f, 0.f, 0.f, 0.f}, acc1 = (f32x4){0.f, 0.f, 0.f, 0.f};
    f32x4 va[2], vb[2];
#pragma unroll
    for (int i = 0; i < 2; ++i) { const int idx = tid + i * 512, rr = idx >> 4, c4 = idx & 15;
        va[i] = (f32x4){0.f, 0.f, 0.f, 0.f}; if (r0 + rr < rmax) va[i] = *(const f32x4*)(A + (size_t)(r0 + rr) * lda + acol0 + c4 * 4);
        vb[i] = *(const f32x4*)(Wm + (size_t)rr * 256 + d0 + c4 * 4); }
    for (int cc = 0; cc < 256; cc += 64) {
#pragma unroll
        for (int i = 0; i < 2; ++i) { const int idx = tid + i * 512, rr = idx >> 4, c4 = idx & 15;
            *(LAS f32x4*)(As + rr * 68 + c4 * 4) = va[i];
            LAS float* q = Bt + (c4 * 4) * 68 + rr; q[0] = vb[i][0]; q[68] = vb[i][1]; q[136] = vb[i][2]; q[204] = vb[i][3]; }
        __syncthreads();
        if (cc + 64 < 256) {
#pragma unroll
            for (int i = 0; i < 2; ++i) { const int idx = tid + i * 512, rr = idx >> 4, c4 = idx & 15;
                va[i] = (f32x4){0.f, 0.f, 0.f, 0.f}; if (r0 + rr < rmax) va[i] = *(const f32x4*)(A + (size_t)(r0 + rr) * lda + acol0 + cc + 64 + c4 * 4);
                vb[i] = *(const f32x4*)(Wm + (size_t)(cc + 64 + rr) * 256 + d0 + c4 * 4); } }
#pragma unroll
        for (int ks = 0; ks < 2; ++ks) {
            const LAS float* ap = As + (br * 16 + fr) * 68 + ks * 32 + fq * 8;
            const f32x4 a0 = *(const LAS f32x4*)ap, a1 = *(const LAS f32x4*)(ap + 4);
            u32x4 aw; aw.x = pk_bf16(a0[0], a0[1]); aw.y = pk_bf16(a0[2], a0[3]); aw.z = pk_bf16(a1[0], a1[1]); aw.w = pk_bf16(a1[2], a1[3]);
            const bf16x8 af = __builtin_bit_cast(bf16x8, aw);
#pragma unroll
            for (int bb = 0; bb < 2; ++bb) {
                const LAS float* bp = Bt + ((bc0 + bb) * 16 + fr) * 68 + ks * 32 + fq * 8;
                const f32x4 b0 = *(const LAS f32x4*)bp, b1 = *(const LAS f32x4*)(bp + 4);
                u32x4 bw; bw.x = pk_bf16(b0[0], b0[1]); bw.y = pk_bf16(b0[2], b0[3]); bw.z = pk_bf16(b1[0], b1[1]); bw.w = pk_bf16(b1[2], b1[3]);
                const bf16x8 bf = __builtin_bit_cast(bf16x8, bw);
                if (bb == 0) acc0 = __builtin_amdgcn_mfma_f32_16x16x32_bf16(af, bf, acc0, 0, 0, 0);
                else acc1 = __builtin_amdgcn_mfma_f32_16x16x32_bf16(af, bf, acc1, 0, 0, 0);
            }
        }
        __syncthreads();
    }
#pragma unroll
    for (int bb = 0; bb < 2; ++bb) { const f32x4 cacc = bb ? acc1 : acc0; const int d = (bc0 + bb) * 16 + fr, rl = br * 16 + fq * 4;
        if (TRANS) { bf16_t* dst = (bf16_t*)dstv; u32x2 wv; wv.x = pk_bf16(cacc[0], cacc[1]); wv.y = pk_bf16(cacc[2], cacc[3]);
            *(u32x2*)(dst + (size_t)(n0 + d) * ldd + r0 + rl) = wv;
            float mx = fmaxf(fmaxf(fabsf(cacc[0]), fabsf(cacc[1])), fmaxf(fabsf(cacc[2]), fabsf(cacc[3])));
            mx = fmaxf(mx, __shfl_xor(mx, 16)); mx = fmaxf(mx, __shfl_xor(mx, 32));
            if (fq == 0 && cmaxw) atomicMax(cmaxw + n0 + d, __float_as_uint(mx)); }
        else { float* dst = (float*)dstv;
#pragma unroll
            for (int e = 0; e < 4; ++e) if (r0 + rl + e < rmax) dst[(size_t)(r0 + rl + e) * ldd + n0 + d] = cacc[e]; } }
}
template <int NR>
__device__ __forceinline__ void p0_rows(const Params& p, int r, int nw, int lane) {
    bf16_t* H = (bf16_t*)(p.ws + WS_H);
    f32x4 v[NR][8];
#pragma unroll
    for (int k = 0; k < NR; ++k) { const int row = r + k * nw; const float* x = row < TP ? p.xp + (size_t)row * D : p.xs + (size_t)(row - TP) * D;
#pragma unroll
        for (int i = 0; i < 4; ++i) { v[k][2 * i] = *(const f32x4*)(x + (i * 64 + lane) * 8); v[k][2 * i + 1] = *(const f32x4*)(x + (i * 64 + lane) * 8 + 4); } }
#pragma unroll
    for (int k = 0; k < NR; ++k) { const int row = r + k * nw; float ss = 0.f;
#pragma unroll
        for (int i = 0; i < 8; ++i) ss += (v[k][i][0] * v[k][i][0] + v[k][i][1] * v[k][i][1]) + (v[k][i][2] * v[k][i][2] + v[k][i][3] * v[k][i][3]);
#pragma unroll
        for (int o = 32; o >= 1; o >>= 1) ss += __shfl_xor(ss, o);
        const float rs = rsqrtf(ss * (1.0f / D) + EPS);
        float amax = 0.f;
#pragma unroll
        for (int i = 0; i < 4; ++i) { const f32x4 g0 = *(const f32x4*)(p.ng + (i * 64 + lane) * 8), g1 = *(const f32x4*)(p.ng + (i * 64 + lane) * 8 + 4);
            v[k][2 * i] = v[k][2 * i] * rs * g0; v[k][2 * i + 1] = v[k][2 * i + 1] * rs * g1;
#pragma unroll
            for (int j = 0; j < 4; ++j) amax = fmaxf(amax, fmaxf(fabsf(v[k][2 * i][j]), fabsf(v[k][2 * i + 1][j]))); }
#pragma unroll
        for (int o = 32; o >= 1; o >>= 1) amax = fmaxf(amax, __shfl_xor(amax, o));
        const float qs = amax > 0.f ? 127.0f / amax : 0.f;
        if (lane == 0) ((float*)(p.ws + WS_RSC))[row] = amax * (1.0f / 127.0f);
        int gidx = -1; const int pmr = row >> 8; const bool need16 = pmr >= 128 || (pmr & 31) == 31;
        if (row < TP) { const int pos = row & 8191; if (pos >= 8190) gidx = (row >> 13) * 2 + (pos - 8190); }
        else { const int rsq = row - TP, pos = rsq & 63; if (pos >= 62) gidx = 8 + (rsq >> 6) * 2 + (pos - 62); }
#pragma unroll
        for (int i = 0; i < 4; ++i) { const f32x4 a = v[k][2 * i], c = v[k][2 * i + 1];
            u32x4 w; w.x = pk_bf16(a[0], a[1]); w.y = pk_bf16(a[2], a[3]); w.z = pk_bf16(c[0], c[1]); w.w = pk_bf16(c[2], c[3]);
            if (need16) *(u32x4*)(H + (size_t)row * LDP + (i * 64 + lane) * 8) = w;
            u32x2 w8; w8.x = pk_fp8x4(a[0], a[1], a[2], a[3]); w8.y = pk_fp8x4(c[0], c[1], c[2], c[3]);
            *(u32x2*)(p.ws + WS_H8 + (size_t)row * LD8 + (i * 64 + lane) * 8) = w8;
            u32x2 wi; wi.x = pk_i8x4(a[0] * qs, a[1] * qs, a[2] * qs, a[3] * qs); wi.y = pk_i8x4(c[0] * qs, c[1] * qs, c[2] * qs, c[3] * qs);
            *(u32x2*)(p.ws + WS_H8I + (size_t)row * LD8 + (i * 64 + lane) * 8) = wi;
            if (gidx >= 0) *(u32x4*)((bf16_t*)(p.ws + WS_HG) + (size_t)gidx * LDP + (i * 64 + lane) * 8) = w; } }
}

__device__ __forceinline__ void phase_colmax(const Params& p, LAS unsigned char* lds) {
    LAS f32x4* red = (LAS f32x4*)lds;
    unsigned* cm = (unsigned*)(p.ws + WS_CMAX);
    const int t = threadIdx.x, cq = t % 80, sg = t / 80;
    for (int blk = blockIdx.x; blk < 256; blk += gridDim.x) {
        const int rg = blk >> 4, cb = blk & 15, col = 1024 + cb * 320 + cq * 4;
        f32x4 m = (f32x4){0.f, 0.f, 0.f, 0.f};
        if (sg < 6) for (int r = rg * 128 + sg; r < rg * 128 + 128; r += 6) { const f32x4 v = *(const f32x4*)(p.win + (size_t)r * NIN + col);
            m[0] = fmaxf(m[0], fabsf(v[0])); m[1] = fmaxf(m[1], fabsf(v[1])); m[2] = fmaxf(m[2], fabsf(v[2])); m[3] = fmaxf(m[3], fabsf(v[3])); }
        if (sg < 6) red[sg * 80 + cq] = m;
        __syncthreads();
        if (sg == 0) {
#pragma unroll
            for (int k = 1; k < 6; ++k) { const f32x4 o = red[k * 80 + cq]; m[0] = fmaxf(m[0], o[0]); m[1] = fmaxf(m[1], o[1]); m[2] = fmaxf(m[2], o[2]); m[3] = fmaxf(m[3], o[3]); }
#pragma unroll
            for (int j = 0; j < 4; ++j) atomicMax(cm + col + j, __float_as_uint(m[j]));
        }
        __syncthreads();
    }
    { int t2 = threadIdx.x; asm volatile("" : "+v"(t2));
      for (int j = blockIdx.x; j < 512; j += gridDim.x) { const int kc = j >> 4, dc = j & 15, g = dc >> 2, d0 = (dc & 3) * 64;
        mm_tile<true>((LAS float*)lds, t2, p.win, NIN, kc * 64, 2048, g * 256, p.wmix + (size_t)g * 65536, d0, (bf16_t*)(p.ws + WS_BIN), LDP, g * 256 + d0, (unsigned*)(p.ws + WS_CMAXW)); } }
    if (blockIdx.x == 0) { u32x4 z = (u32x4){0u, 0u, 0u, 0u}; u32x4* hg = (u32x4*)(p.ws + WS_HG + (size_t)72 * LDP * 2);
        for (int i = threadIdx.x; i < (256 - 72) * LDP * 2 / 16; i += NTHREADS) hg[i] = z; }
}

__device__ __forceinline__ void phase0(const Params& p, LAS unsigned char* lds) {
    LAS float* sm = (LAS float*)lds;
    int t_ = threadIdx.x; asm volatile("" : "+v"(t_));
    const int G = gridDim.x, b = blockIdx.x, tid = t_, lane = tid & 63, wid = tid >> 6;
    bf16_t* BIN = (bf16_t*)(p.ws + WS_BIN);
    for (int d = b * 8 + wid; d < 1024; d += G * 8) {
        const float cmx = ((const float*)(p.ws + WS_CMAXW))[d], sc = cmx > 0.f ? 127.0f / cmx : 0.f;
        const u32x4* src = (const u32x4*)(BIN + (size_t)d * LDP + lane * 32);
        u32x4 o[2];
#pragma unroll
        for (int h = 0; h < 2; ++h) { const u32x4 w0 = src[2 * h], w1 = src[2 * h + 1];
            o[h].x = pk_i8x4(bf_lo(w0.x) * sc, bf_hi(w0.x) * sc, bf_lo(w0.y) * sc, bf_hi(w0.y) * sc); o[h].y = pk_i8x4(bf_lo(w0.z) * sc, bf_hi(w0.z) * sc, bf_lo(w0.w) * sc, bf_hi(w0.w) * sc);
            o[h].z = pk_i8x4(bf_lo(w1.x) * sc, bf_hi(w1.x) * sc, bf_lo(w1.y) * sc, bf_hi(w1.y) * sc); o[h].w = pk_i8x4(bf_lo(w1.z) * sc, bf_hi(w1.z) * sc, bf_lo(w1.w) * sc, bf_hi(w1.w) * sc); }
        u32x4* dst = (u32x4*)(p.ws + WS_BIN8I + (size_t)(5120 + d) * LD8 + lane * 32);
        dst[0] = o[0]; dst[1] = o[1];
        if (lane == 0) ((float*)(p.ws + WS_CSV))[5120 + d] = cmx * (1.0f / 127.0f);
    }
    for (int j = b; j < 128; j += G) { const int rc = j >> 4, dc = j & 15, g = dc >> 2, d0 = (dc & 3) * 64;
        mm_tile<false>(sm, tid, p.spool, 1024, rc * 64, 480, g * 256, p.wmix + (size_t)g * 65536, d0, (float*)(p.ws + WS_BUFM), 1024, g * 256 + d0, nullptr); }
    tr_all(p, sm, b, G, tid);
    const int gw = b * 8 + wid, nw = G * 8;
    int r = gw;
    for (; r + nw < T; r += 2 * nw) p0_rows<2>(p, r, nw, lane);
    if (r < T) p0_rows<1>(p, r, nw, lane);
}

template <bool SAMPLE>
__device__ __forceinline__ void stencil_run(const Params& p, int seq, int t0, int nT, int c0) {
    const bf16_t* __restrict__ XM = (const bf16_t*)(p.ws + WS_XM); const bf16_t* __restrict__ SA = (const bf16_t*)(p.ws + WS_SA);
    const bf16_t* __restrict__ U = (const bf16_t*)(p.ws + WS_U); const bf16_t* __restrict__ G2 = (const bf16_t*)(p.ws + WS_G2);
    const float* __restrict__ BUFM = (const float*)(p.ws + WS_BUFM);
    bf16_t* __restrict__ YC = (bf16_t*)(p.ws + WS_H);
    const int rowbase = SAMPLE ? TP + seq * 64 : seq * 8192;
    const int w = 2 << (c0 >> 8);
    float sp[8], um1[8], um2[8], sc[8], w0[8], w1[8], w2[8];
#pragma unroll
    for (int j = 0; j < 8; ++j) { sp[j] = 0.f; sc[j] = p.pscale[c0 + j]; w0[j] = p.wconv[c0 + j]; w1[j] = p.wconv[1024 + c0 + j]; w2[j] = p.wconv[2048 + c0 + j]; }
    for (int i = 1; i < w; ++i) { const int t = t0 - i;
        if (t >= 0) { const u32x4 v = *(const u32x4*)(XM + (size_t)(rowbase + t) * 1024 + c0);
            sp[0] += bf_lo(v.x); sp[1] += bf_hi(v.x); sp[2] += bf_lo(v.y); sp[3] += bf_hi(v.y); sp[4] += bf_lo(v.z); sp[5] += bf_hi(v.z); sp[6] += bf_lo(v.w); sp[7] += bf_hi(v.w); }
        else if (SAMPLE) { const float* q = BUFM + (size_t)(seq * 15 + 15 + t) * 1024 + c0;
#pragma unroll
            for (int j = 0; j < 8; ++j) sp[j] += q[j]; } }
#pragma unroll
    for (int k = 1; k <= 2; ++k) { const int t = t0 - k; float tmp[8];
        if (t >= 0) { const u32x4 v = *(const u32x4*)(U + (size_t)(rowbase + t) * 1024 + c0);
            tmp[0] = bf_lo(v.x); tmp[1] = bf_hi(v.x); tmp[2] = bf_lo(v.y); tmp[3] = bf_hi(v.y); tmp[4] = bf_lo(v.z); tmp[5] = bf_hi(v.z); tmp[6] = bf_lo(v.w); tmp[7] = bf_hi(v.w); }
        else if (SAMPLE) { const float* q = p.sconv + (size_t)(seq * 2 + 2 + t) * 1024 + c0;
#pragma unroll
            for (int j = 0; j < 8; ++j) tmp[j] = q[j]; }
        else {
#pragma unroll
            for (int j = 0; j < 8; ++j) tmp[j] = 0.f; }
#pragma unroll
        for (int j = 0; j < 8; ++j) { if (k == 1) um1[j] = tmp[j]; else um2[j] = tmp[j]; } }
#pragma unroll 2
    for (int s = 0; s < nT; ++s) { const int t = t0 + s; const size_t ro = (size_t)(rowbase + t) * 1024 + c0;
        const u32x4 xv = *(const u32x4*)(XM + ro), sv = *(const u32x4*)(SA + ro), uv = *(const u32x4*)(U + ro), gv = *(const u32x4*)(G2 + ro);
        float xo[8]; const int to = t - (w - 1);
        if (to >= 0) { const u32x4 v = *(const u32x4*)(XM + (size_t)(rowbase + to) * 1024 + c0);
            xo[0] = bf_lo(v.x); xo[1] = bf_hi(v.x); xo[2] = bf_lo(v.y); xo[3] = bf_hi(v.y); xo[4] = bf_lo(v.z); xo[5] = bf_hi(v.z); xo[6] = bf_lo(v.w); xo[7] = bf_hi(v.w); }
        else if (SAMPLE) { const float* q = BUFM + (size_t)(seq * 15 + 15 + to) * 1024 + c0;
#pragma unroll
            for (int j = 0; j < 8; ++j) xo[j] = q[j]; }
        else {
#pragma unroll
            for (int j = 0; j < 8; ++j) xo[j] = 0.f; }
        const float xc[8] = {bf_lo(xv.x), bf_hi(xv.x), bf_lo(xv.y), bf_hi(xv.y), bf_lo(xv.z), bf_hi(xv.z), bf_lo(xv.w), bf_hi(xv.w)};
        const float sa[8] = {bf_lo(sv.x), bf_hi(sv.x), bf_lo(sv.y), bf_hi(sv.y), bf_lo(sv.z), bf_hi(sv.z), bf_lo(sv.w), bf_hi(sv.w)};
        const float uc[8] = {bf_lo(uv.x), bf_hi(uv.x), bf_lo(uv.y), bf_hi(uv.y), bf_lo(uv.z), bf_hi(uv.z), bf_lo(uv.w), bf_hi(uv.w)};
        const float g2[8] = {bf_lo(gv.x), bf_hi(gv.x), bf_lo(gv.y), bf_hi(gv.y), bf_lo(gv.z), bf_hi(gv.z), bf_lo(gv.w), bf_hi(gv.w)};
        const int cnt = SAMPLE ? w : ((t + 1) < w ? (t + 1) : w);
        const float inv = 1.0f / (float)cnt;
        float ya[8], yb[8];
#pragma unroll
        for (int j = 0; j < 8; ++j) { const float S = sp[j] + xc[j]; ya[j] = (S * inv - xc[j]) * sc[j] * sa[j]; sp[j] = S - xo[j];
            yb[j] = g2[j] * (w0[j] * um2[j] + w1[j] * um1[j] + w2[j] * uc[j]); um2[j] = um1[j]; um1[j] = uc[j]; }
        u32x4 wa, wb;
        wa.x = pk_bf16(ya[0], ya[1]); wa.y = pk_bf16(ya[2], ya[3]); wa.z = pk_bf16(ya[4], ya[5]); wa.w = pk_bf16(ya[6], ya[7]);
        wb.x = pk_bf16(yb[0], yb[1]); wb.y = pk_bf16(yb[2], yb[3]); wb.z = pk_bf16(yb[4], yb[5]); wb.w = pk_bf16(yb[6], yb[7]);
        bf16_t* yo = YC + (size_t)(rowbase + t) * LDP + c0;
        *(u32x4*)yo = wa; *(u32x4*)(yo + 1024) = wb; }
}

__device__ __forceinline__ void phase2(const Params& p) {
    int t_ = threadIdx.x; asm volatile("" : "+v"(t_));
    const int NT = gridDim.x * NTHREADS, gt = blockIdx.x * NTHREADS + t_;
    for (int id = gt; id < 131072; id += NT) { const int cg8 = id & 127, run = id >> 7; stencil_run<false>(p, run >> 8, (run & 255) * 32, 32, cg8 * 8); }
    for (int id = gt; id < 131072; id += NT) { const int cg8 = id & 127, run = id >> 7; stencil_run<true>(p, run >> 5, (run & 31) * 2, 2, cg8 * 8); }
}

template <int NR>
__device__ __forceinline__ void p5_rows(const Params& p, const bf16_t* __restrict__ DL, int r, int nw, int lane) {
    f32x4 v[NR][8]; u32x4 d[NR][4];
#pragma unroll
    for (int k = 0; k < NR; ++k) { const int row = r + k * nw; const float* x = row < TP ? p.xp + (size_t)row * D : p.xs + (size_t)(row - TP) * D;
#pragma unroll
        for (int i = 0; i < 4; ++i) { v[k][2 * i] = *(const f32x4*)(x + (i * 64 + lane) * 8); v[k][2 * i + 1] = *(const f32x4*)(x + (i * 64 + lane) * 8 + 4);
            d[k][i] = *(const u32x4*)(DL + (size_t)row * LDP + (i * 64 + lane) * 8); } }
#pragma unroll
    for (int k = 0; k < NR; ++k) { const int row = r + k * nw; float ss = 0.f;
#pragma unroll
        for (int i = 0; i < 4; ++i) { const u32x4 w = d[k][i];
            v[k][2 * i] += (f32x4){bf_lo(w.x), bf_hi(w.x), bf_lo(w.y), bf_hi(w.y)}; v[k][2 * i + 1] += (f32x4){bf_lo(w.z), bf_hi(w.z), bf_lo(w.w), bf_hi(w.w)}; }
#pragma unroll
        for (int i = 0; i < 8; ++i) ss += (v[k][i][0] * v[k][i][0] + v[k][i][1] * v[k][i][1]) + (v[k][i][2] * v[k][i][2] + v[k][i][3] * v[k][i][3]);
#pragma unroll
        for (int o = 32; o >= 1; o >>= 1) ss += __shfl_xor(ss, o);
        const float rs = rsqrtf(ss * (1.0f / D) + EPS);
        float* y = p.out + O_Y + (size_t)row * D;
#pragma unroll
        for (int i = 0; i < 4; ++i) { const f32x4 g0 = *(const f32x4*)(p.fng + (i * 64 + lane) * 8), g1 = *(const f32x4*)(p.fng + (i * 64 + lane) * 8 + 4);
            *(f32x4*)(y + (i * 64 + lane) * 8) = v[k][2 * i] * rs * g0; *(f32x4*)(y + (i * 64 + lane) * 8 + 4) = v[k][2 * i + 1] * rs * g1; } }
}
__device__ __forceinline__ void phase5(const Params& p) {
    int t_ = threadIdx.x; asm volatile("" : "+v"(t_));
    const int lane = t_ & 63, gw = blockIdx.x * 8 + (t_ >> 6), nw = gridDim.x * 8;
    const bf16_t* DL = (const bf16_t*)(p.ws + WS_H);
    int r = gw;
    for (; r + nw < T; r += 2 * nw) p5_rows<2>(p, DL, r, nw, lane);
    if (r < T) p5_rows<1>(p, DL, r, nw, lane);
}


#define XB_TMO      128
#define XB_XCNT(j)  (256  + 64 * (j))
#define XB_XSUB(j)  (1280 + 64 * (j))
#define XB_XGEN(j)  (2304 + 64 * (j))
#define XB_TOP      3328
#define XB_TOPGEN   3392
#define XCD_BAR_WORDS 3456
#define XB_SPIN_CAP (1u << 18)
__device__ __forceinline__ unsigned xb_ld(unsigned* p)              { return __hip_atomic_load(p, __ATOMIC_RELAXED, __HIP_MEMORY_SCOPE_AGENT); }
__device__ __forceinline__ unsigned xb_add(unsigned* p, unsigned v) { return __hip_atomic_fetch_add(p, v, __ATOMIC_RELAXED, __HIP_MEMORY_SCOPE_AGENT); }
__device__ __forceinline__ unsigned xb_xcc_id() { return (unsigned)__builtin_amdgcn_s_getreg((3 << 11) | 20) & 0xFu; }
#define XB_SPIN(cond, bar) do { unsigned _sp = 0; while (cond) { __builtin_amdgcn_s_sleep(1); \
    if ((++_sp & 255u) == 0u) { if (xb_ld(&(bar)[XB_TMO])) break; if (_sp > XB_SPIN_CAP) { atomicAdd(&(bar)[XB_TMO], 1u); break; } } } } while (0)
struct XcdBarrier { unsigned* bar; unsigned x; volatile LAS unsigned* st; };
__device__ __forceinline__ XcdBarrier xcd_barrier_post(unsigned* bar, volatile LAS unsigned* st) {
    XcdBarrier b; b.bar = bar; b.x = xb_xcc_id(); b.st = st;
    if (threadIdx.x == 0) (void)xb_add(&bar[XB_XCNT(b.x)], 1u);
    return b;
}
__device__ __forceinline__ void xcd_barrier_complete(unsigned* bar, unsigned x, unsigned& nloc, unsigned& nx) {
    const unsigned G = gridDim.x * gridDim.y * gridDim.z;
    unsigned sum, cnt, mine, sp = 0u;
    for (;;) {
        sum = 0u; cnt = 0u; mine = 0u;
#pragma unroll
        for (unsigned j = 0; j < 16; ++j) { const unsigned c = xb_ld(&bar[XB_XCNT(j)]); sum += c; cnt += (c > 0u) ? 1u : 0u; mine = (j == x) ? c : mine; }
        if (sum == G) break;
        __builtin_amdgcn_s_sleep(1);
        if ((++sp & 255u) == 0u) { if (xb_ld(&bar[XB_TMO])) break; if (sp > XB_SPIN_CAP) { atomicAdd(&bar[XB_TMO], 1u); break; } }
    }
    nloc = mine > 0u ? mine : 1u; nx = cnt > 0u ? cnt : 1u;
}
__device__ __forceinline__ void xcd_barrier(const XcdBarrier& b) {
    asm volatile("s_waitcnt vmcnt(0)" ::: "memory");
    __syncthreads();
    if (threadIdx.x == 0) {
        unsigned* bar = b.bar;
        __builtin_amdgcn_s_waitcnt(0);
        unsigned nloc = b.st[0], nx = b.st[1];
        if (nloc == 0u) { xcd_barrier_complete(bar, b.x, nloc, nx); b.st[0] = nloc; b.st[1] = nx; }
        const unsigned old = xb_add(&bar[XB_XSUB(b.x)], 1u);
        const unsigned gen = old / nloc;
        if (old + 1u == (gen + 1u) * nloc) {
            __builtin_amdgcn_fence(__ATOMIC_RELEASE, "agent");
            asm volatile("s_waitcnt vmcnt(0)" ::: "memory");
            const unsigned og = xb_add(&bar[XB_TOP], 1u);
            const unsigned tg = og / nx;
            if (og + 1u == (tg + 1u) * nx) xb_add(&bar[XB_TOPGEN], 1u);
            else XB_SPIN(xb_ld(&bar[XB_TOPGEN]) == tg, bar);
            __builtin_amdgcn_fence(__ATOMIC_ACQUIRE, "agent");
            xb_add(&bar[XB_XGEN(b.x)], 1u);
            asm volatile("s_waitcnt vmcnt(0)" ::: "memory");
        } else {
            XB_SPIN(xb_ld(&bar[XB_XGEN(b.x)]) == gen, bar);
            __builtin_amdgcn_fence(__ATOMIC_ACQUIRE, "agent");
            asm volatile("s_waitcnt vmcnt(0)" ::: "memory");
        }
    }
    __syncthreads();
}

__global__ void __launch_bounds__(NTHREADS, 2) fwd_megakernel(Params p) {
    extern __shared__ __attribute__((aligned(16))) unsigned char lds_raw[];
    LAS unsigned char* lds = (LAS unsigned char*)lds_raw;
    const int G = gridDim.x, c = blockIdx.x;
    volatile LAS unsigned* xst = (volatile LAS unsigned*)(lds + STAGE_BYTES);
    unsigned* barw = (unsigned*)(p.ws + WS_BAR);
    if (threadIdx.x < 2) xst[threadIdx.x] = 0u;
    __syncthreads();
    const XcdBarrier xb = xcd_barrier_post(barw, xst);

    phase_colmax(p, lds);
    xcd_barrier(xb);
    phase0(p, lds);
    xcd_barrier(xb);
    {
        { Epi1 E{(bf16_t*)(p.ws + WS_XM), (bf16_t*)(p.ws + WS_SA), (bf16_t*)(p.ws + WS_U), (bf16_t*)(p.ws + WS_G2), p.out};
          GemmDesc g{(const bf16_t*)(p.ws + WS_H), (const bf16_t*)(p.ws + WS_BIN), LDP, LDP, 32, (const bf16_t*)(p.ws + WS_HG), (const bf16_t*)(p.ws + WS_BIN)}; Sched1a S{G, c}; gemm_phase<0>(lds, g, S, E); }
        { EpiI8 E8{(bf16_t*)(p.ws + WS_SA), (bf16_t*)(p.ws + WS_U), (bf16_t*)(p.ws + WS_G2), (const float*)(p.ws + WS_RSC), (const float*)(p.ws + WS_CSV)};
          GemmDesc g{(const bf16_t*)(p.ws + WS_H8I), (const bf16_t*)(p.ws + WS_BIN8I - (size_t)4 * 256 * LD8), LD8 / 2, LD8 / 2, 16, nullptr, nullptr}; Sched1c S{G, c}; gemm_phase<2>(lds, g, S, E8); }
    }
    xcd_barrier(xb);
    phase2(p);
    {
        GemmDesc g{(const bf16_t*)(p.ws + WS_H8), (const bf16_t*)(p.ws + WS_BIN8 - (size_t)24 * 256 * LD8), LD8 / 2, LD8 / 2, 16, nullptr, nullptr}; Sched1b S{G, c};
        EpiGG EG{(bf16_t*)(p.ws + WS_SGR), (bf16_t*)(p.ws + WS_SGB), p.bgate, 1.0f / W8_SCALE}; gemm_phase<1>(lds, g, S, EG);
    }
    xcd_barrier(xb);
    {
        GemmDesc g{(const bf16_t*)(p.ws + WS_H), (const bf16_t*)(p.ws + WS_BP), LDP, LDP, 16, (const bf16_t*)(p.ws + WS_MG), (const bf16_t*)(p.ws + WS_BO)};
        EpiMix E{EpiD{(const bf16_t*)(p.ws + WS_SGR), (const bf16_t*)(p.ws + WS_SGB), (bf16_t*)(p.ws + WS_MG)}, EpiE{(bf16_t*)(p.ws + WS_H)}};
        { SchedA S{G, c}; gemm_phase<0>(lds, g, S, E); }
        xcd_barrier(xb);
        { SchedB S{G, c}; gemm_phase<0>(lds, g, S, E); }
        xcd_barrier(xb);
        { SchedC S{G, c}; gemm_phase<0>(lds, g, S, E); }
    }
    xcd_barrier(xb);
    phase5(p);
}

extern "C" void kernel_launch(void* const* d_in, const int* in_sizes, int n_in, void* d_out, int out_size, void* d_ws, size_t ws_size, hipStream_t stream) {
    static int grid_blocks = 0;
    if (grid_blocks == 0) {
        if (ws_size < WS_END) { fprintf(stderr, "kernel_launch: workspace too small: %zu < %zu\n", ws_size, (size_t)WS_END); grid_blocks = -1; return; }
        int dev = 0, cus = 0, per_cu = 0;
        hipGetDevice(&dev);
        hipDeviceGetAttribute(&cus, hipDeviceAttributeMultiprocessorCount, dev);
        if (hipFuncSetAttribute((const void*)fwd_megakernel, hipFuncAttributeMaxDynamicSharedMemorySize, LDS_BYTES) != hipSuccess) { fprintf(stderr, "kernel_launch: hipFuncSetAttribute failed\n"); grid_blocks = -1; return; }
        if (hipOccupancyMaxActiveBlocksPerMultiprocessor(&per_cu, (const void*)fwd_megakernel, NTHREADS, LDS_BYTES) != hipSuccess || per_cu < 1) { fprintf(stderr, "kernel_launch: occupancy query failed (%d)\n", per_cu); (void)hipGetLastError(); per_cu = 1; }
        grid_blocks = cus * per_cu;
        if (grid_blocks > 256) grid_blocks = 256;
    }
    if (grid_blocks < 0) return;
    Params p{};
    p.xp = (const float*)d_in[0]; p.xs = (const float*)d_in[1]; p.spool = (const float*)d_in[2]; p.sconv = (const float*)d_in[3]; p.ng = (const float*)d_in[4];
    p.win = (const float*)d_in[5]; p.bgate = (const float*)d_in[6]; p.wmix = (const float*)d_in[7]; p.pscale = (const float*)d_in[8]; p.wconv = (const float*)d_in[9];
    p.wpp = (const float*)d_in[10]; p.wpc = (const float*)d_in[11]; p.wout = (const float*)d_in[12]; p.fng = (const float*)d_in[13];
    p.out = (float*)d_out; p.ws = (unsigned char*)d_ws;
    if (hipMemsetAsync((char*)d_ws + WS_BAR, 0, ZERO_BYTES, stream) != hipSuccess) { fprintf(stderr, "kernel_launch: hipMemsetAsync of the barrier words failed\n"); return; }
    void* args[] = {&p};
    hipError_t e = hipLaunchCooperativeKernel((const void*)fwd_megakernel, dim3(grid_blocks), dim3(NTHREADS), args, LDS_BYTES, stream);
    if (e != hipSuccess) fprintf(stderr, "cooperative launch failed: %s (grid %d)\n", hipGetErrorString(e), grid_blocks);
}
```

```cpp
#include <hip/hip_runtime.h>
#include <hip/hip_cooperative_groups.h>
#include <cstdio>
namespace cg = cooperative_groups;

#define LAS __attribute__((address_space(3)))
typedef unsigned short bf16_t;
typedef short bf16x8 __attribute__((ext_vector_type(8)));
typedef float f32x4 __attribute__((ext_vector_type(4)));
typedef unsigned u32x4 __attribute__((ext_vector_type(4)));
typedef unsigned u32x2 __attribute__((ext_vector_type(2)));
typedef int i32x4 __attribute__((ext_vector_type(4)));
typedef int i32x8 __attribute__((ext_vector_type(8)));

constexpr int D = 2048, TP = 32768, TS = 2048, T = TP + TS;
constexpr int NIN = 10240;
constexpr int LDP = 2048 + 64;
constexpr float EPS = 1e-6f;
constexpr int LD8 = 2048 + 128;
constexpr float W8_SCALE = 64.0f;
constexpr int BM = 256, BK = 64, HALF = 128, HTB = HALF * BK * 2, STAGE_BYTES = 8 * HTB;
constexpr int NTHREADS = 512;
constexpr int LDS_BYTES = STAGE_BYTES + 256;

constexpr size_t O_Y = 0, O_NPP = 71303168, O_NCP = 71364608, O_NPS = 71372800, O_NCS = 71864320;
constexpr size_t WS_H = 0;
constexpr size_t WS_BIN = WS_H + (size_t)T * LDP * 2;
constexpr size_t WS_BP = WS_BIN + (size_t)11264 * LDP * 2;
constexpr size_t WS_BO = WS_BP + (size_t)2048 * LDP * 2;
constexpr size_t WS_XM = WS_BO + (size_t)2048 * LDP * 2;
constexpr size_t WS_SA = WS_XM + (size_t)T * 1024 * 2;
constexpr size_t WS_U = WS_SA + (size_t)T * 1024 * 2;
constexpr size_t WS_G2 = WS_U + (size_t)T * 1024 * 2;
constexpr size_t WS_SGR = WS_G2 + (size_t)T * 1024 * 2;
constexpr size_t WS_SGB = WS_SGR + (size_t)T * 2048 * 2;
constexpr size_t WS_BUFM = WS_SGB + (size_t)T * 2048 * 2;
constexpr size_t WS_SS = WS_BUFM + (size_t)32 * 15 * 1024 * 4;
constexpr size_t WS_BAR = WS_SS + (size_t)T * 32 * 4;
constexpr size_t WS_CMAX = WS_BAR + 16384;
constexpr size_t WS_CMAXW = WS_CMAX + 10240 * 4;
constexpr size_t ZERO_BYTES = 16384 + 10240 * 4 + 1024 * 4;
constexpr size_t WS_H8 = WS_CMAXW + 1024 * 4;
constexpr size_t WS_BIN8 = WS_H8 + (size_t)T * LD8;
constexpr size_t WS_H8I = WS_BIN8 + (size_t)4096 * LD8;
constexpr size_t WS_BIN8I = WS_H8I + (size_t)T * LD8;
constexpr size_t WS_CSV = WS_BIN8I + (size_t)6144 * LD8;
constexpr size_t WS_RSC = WS_CSV + 6144 * 4;
constexpr size_t WS_HG = WS_RSC + (size_t)T * 4;
constexpr size_t WS_HX = WS_HG + (size_t)256 * LDP * 2;
constexpr size_t WS_END = WS_HX + (size_t)12 * 256 * LDP * 2;
constexpr size_t WS_MG = WS_XM;

struct Params {
    const float *xp, *xs, *spool, *sconv, *ng, *win, *bgate, *wmix, *pscale, *wconv, *wpp, *wpc, *wout, *fng;
    float* out; unsigned char* ws;
};

typedef float f32x2_t __attribute__((ext_vector_type(2)));
typedef __bf16 bf16x2_t __attribute__((ext_vector_type(2)));
__device__ __forceinline__ unsigned pk_bf16(float lo, float hi) { const f32x2_t v = {lo, hi}; return __builtin_bit_cast(unsigned, __builtin_convertvector(v, bf16x2_t)); }
__device__ __forceinline__ unsigned pk_fp8x4(float a, float b, float c, float d) { int w = 0; w = __builtin_amdgcn_cvt_pk_fp8_f32(a, b, w, false); w = __builtin_amdgcn_cvt_pk_fp8_f32(c, d, w, true); return (unsigned)w; }
__device__ __forceinline__ unsigned pk_i8x4(float a, float b, float c, float d) {
    const int q0 = (int)rintf(a), q1 = (int)rintf(b), q2 = (int)rintf(c), q3 = (int)rintf(d);
    return (unsigned)(q0 & 255) | ((unsigned)(q1 & 255) << 8) | ((unsigned)(q2 & 255) << 16) | ((unsigned)q3 << 24); }
__device__ __forceinline__ float bf_lo(unsigned w) { return __uint_as_float(w << 16); }
__device__ __forceinline__ float bf_hi(unsigned w) { return __uint_as_float(w & 0xffff0000u); }
__device__ __forceinline__ float sigmoid_f(float x) { x = fminf(fmaxf(x, -40.f), 40.f); return __builtin_amdgcn_rcpf(1.0f + __builtin_amdgcn_exp2f(-1.44269504f * x)); }
__device__ __forceinline__ float silu_f(float x) { return x * sigmoid_f(x); }

__device__ __forceinline__ int lds_byte(int r, int c) { const int st = (r >> 4) * 2 + (c >> 5), rr = r & 15, cc = c & 31, ob = rr * 64 + cc * 2; return st * 1024 + (ob ^ (((ob >> 9) & 1) << 5)); }
__device__ __forceinline__ void stage_rc(int b, int& R, int& C) { const int st = b / 1024, sb = b % 1024, swz = sb ^ (((sb >> 9) & 1) << 5); R = (st >> 1) * 16 + swz / 64; C = (st & 1) * 32 + (swz % 64) / 2; }
__device__ __forceinline__ int perm32(int rho) { const int n = rho >> 4, i = rho & 15; return 8 * (i >> 2) + 4 * n + (i & 3); }

struct Unit { int pm, pn, kh, type; };
struct GemmDesc { const bf16_t* A; const bf16_t* Bt; int lda, ldb, nt; const bf16_t* A2; const bf16_t* Bt2; };

__device__ __forceinline__ void tile_map(int L, int nM, int nN, int& pm, int& pn) {
    const int nwg = nM * nN; int wgid = L;
    { const int q = nwg / 8, r = nwg % 8, xcd = wgid % 8, off = wgid / 8; wgid = (xcd < r ? xcd * (q + 1) : r * (q + 1) + (xcd - r) * q) + off; }
    const int nig = 8 * nN, gid = wgid / nig, fm = gid * 8, gsz = (nM - fm) < 8 ? (nM - fm) : 8;
    pm = fm + ((wgid % nig) % gsz); pn = (wgid % nig) / gsz;
}

template <int MODE  , class Epi, class Sched>
__device__ __forceinline__ void gemm_phase(LAS unsigned char* lds, const GemmDesc g, const Sched& S, const Epi& E) {
    int tid_ = threadIdx.x; asm volatile("" : "+v"(tid_));
    const int tid = tid_, wid = __builtin_amdgcn_readfirstlane(tid >> 6), lane = tid & 63, wr = wid >> 2, wc = wid & 3, fr = lane & 15, fq = lane >> 4;
    const int nt = g.nt;
    unsigned voffA[2], voffB[2];
#pragma unroll
    for (int i = 0; i < 2; ++i) { int R, C; stage_rc(tid * 16 + i * 8192, R, C); const int Rb = (R & ~31) + perm32(R & 31);
        voffA[i] = (unsigned)(R * g.lda + C) * 2u; voffB[i] = (unsigned)(Rb * g.ldb + C) * 2u; }
    const size_t kstep = (size_t)(BK * 2);
    const size_t hstepA = (size_t)HALF * g.lda * 2, hstepB = (size_t)HALF * g.ldb * 2;
    const size_t khb = (size_t)nt * kstep;
    const unsigned ldsw = (unsigned)wid * 1024u;
    const int aoff = lds_byte(wr * 64 + fr, fq * 8), boff = lds_byte(wc * 32 + fr, fq * 8);
#define G_SA(b, h) (((b) * 2 + (h)) * HTB)
#define G_SB(b, h) ((4 + (b) * 2 + (h)) * HTB)
#define G_STAGE(bufoff, gbase, voff) do { _Pragma("unroll") for (int _i = 0; _i < 2; ++_i) \
        __builtin_amdgcn_global_load_lds((const unsigned*)((const char*)(gbase) + (voff)[_i]), (LAS unsigned*)(lds + (bufoff) + ldsw + _i * 8192), 16, 0, 0); } while (0)
#define G_LDA(dst, b, h) do { if constexpr (MODE == 1) { _Pragma("unroll") for (int m = 0; m < 4; ++m) { dst##8[m].lo = *(const LAS i32x4*)(lds + G_SA(b, h) + aoff + m * 2048); dst##8[m].hi = *(const LAS i32x4*)(lds + G_SA(b, h) + aoff + m * 2048 + 1024); } } \
        else { _Pragma("unroll") for (int m = 0; m < 4; ++m) _Pragma("unroll") for (int k = 0; k < 2; ++k) dst[m][k] = *(const LAS bf16x8*)(lds + G_SA(b, h) + aoff + m * 2048 + k * 1024); } } while (0)
#define G_LDB(dst, b, h) do { if constexpr (MODE == 1) { _Pragma("unroll") for (int n = 0; n < 2; ++n) { dst##8[n].lo = *(const LAS i32x4*)(lds + G_SB(b, h) + boff + n * 2048); dst##8[n].hi = *(const LAS i32x4*)(lds + G_SB(b, h) + boff + n * 2048 + 1024); } } \
        else { _Pragma("unroll") for (int n = 0; n < 2; ++n) _Pragma("unroll") for (int k = 0; k < 2; ++k) dst[n][k] = *(const LAS bf16x8*)(lds + G_SB(b, h) + boff + n * 2048 + k * 1024); } } while (0)
#define G_MMA(ai, bj, At, Bt) do { __builtin_amdgcn_s_setprio(1); \
        if constexpr (MODE == 1) { _Pragma("unroll") for (int m = 0; m < 4; ++m) _Pragma("unroll") for (int n = 0; n < 2; ++n) \
            asm volatile("v_mfma_scale_f32_16x16x128_f8f6f4 %0, %1, %2, %0, %3, %3 op_sel_hi:[0,0,0]" : "+v"(acc[ai][bj][m][n]) : "v"(Bt##8[n]), "v"(At##8[m]), "v"(one_scale)); } \
        else { _Pragma("unroll") for (int m = 0; m < 4; ++m) _Pragma("unroll") for (int n = 0; n < 2; ++n) _Pragma("unroll") for (int k = 0; k < 2; ++k) \
            { if constexpr (MODE == 2) acc[ai][bj][m][n] = __builtin_bit_cast(f32x4, __builtin_amdgcn_mfma_i32_16x16x64_i8(__builtin_bit_cast(i32x4, Bt[n][k]), __builtin_bit_cast(i32x4, At[m][k]), __builtin_bit_cast(i32x4, acc[ai][bj][m][n]), 0, 0, 0)); \
              else acc[ai][bj][m][n] = __builtin_amdgcn_mfma_f32_16x16x32_bf16(Bt[n][k], At[m][k], acc[ai][bj][m][n], 0, 0, 0); } } \
        __builtin_amdgcn_s_setprio(0); } while (0)
#define G_WAIT_V(n) asm volatile("s_waitcnt vmcnt(" #n ")" ::: "memory")
#define G_WAIT_L(n) asm volatile("s_waitcnt lgkmcnt(" #n ")" ::: "memory")
#define G_BAR __builtin_amdgcn_s_barrier()
#define G_SCHED __builtin_amdgcn_sched_barrier(0)
    Unit cur, nxt; int ui = 0;
    if (!S.next(0, cur)) return;
    f32x4 acc[2][2][4][2];
#pragma unroll
    for (int a = 0; a < 2; ++a)
#pragma unroll
        for (int b = 0; b < 2; ++b)
#pragma unroll
            for (int m = 0; m < 4; ++m)
#pragma unroll
                for (int n = 0; n < 2; ++n) acc[a][b][m][n] = (f32x4){0.f, 0.f, 0.f, 0.f};
    bf16x8 At[4][2], B0[2][2], B1[2][2];
    const int one_scale = 0x7f7f7f7f;
    i32x8 At8[4], B08[2], B18[2];
    const char* cA = (const char*)(cur.type ? g.A2 : g.A) + (size_t)cur.pm * 2 * hstepA + (size_t)cur.kh * khb;
    const char* cB = (const char*)(cur.type ? g.Bt2 : g.Bt) + (size_t)cur.pn * 2 * hstepB + (size_t)cur.kh * khb;
    G_STAGE(G_SB(0, 0), cB, voffB); G_STAGE(G_SA(0, 0), cA, voffA); G_STAGE(G_SB(0, 1), cB + hstepB, voffB); G_STAGE(G_SA(0, 1), cA + hstepA, voffA);
    if (wr == 1) G_BAR;
    G_WAIT_V(4); G_BAR;
    G_STAGE(G_SB(1, 0), cB + kstep, voffB); G_STAGE(G_SA(1, 0), cA + kstep, voffA); G_STAGE(G_SB(1, 1), cB + hstepB + kstep, voffB);
    G_WAIT_V(6); G_BAR;
    for (;;) {
        const bool has_next = S.next(ui + 1, nxt);
        const char* nA = has_next ? (const char*)(nxt.type ? g.A2 : g.A) + (size_t)nxt.pm * 2 * hstepA + (size_t)nxt.kh * khb : cA;
        const char* nB = has_next ? (const char*)(nxt.type ? g.Bt2 : g.Bt) + (size_t)nxt.pn * 2 * hstepB + (size_t)nxt.kh * khb : cB;
        for (int t = 0; t < nt; t += 2) {
            const bool last = (t == nt - 2);
            const char* a1 = cA + (size_t)(t + 1) * kstep;
            const char* a2 = last ? nA : cA + (size_t)(t + 2) * kstep; const char* b2 = last ? nB : cB + (size_t)(t + 2) * kstep;
            const char* a3 = a2 + kstep; const char* b3 = b2 + kstep;
            G_LDB(B0, 0, 0); G_SCHED; G_LDA(At, 0, 0); G_STAGE(G_SA(1, 1), a1 + hstepA, voffA);
            G_WAIT_L(8); G_BAR; G_WAIT_L(0); G_MMA(0, 0, At, B0); G_BAR; G_SCHED;
            G_LDB(B1, 0, 1); G_STAGE(G_SB(0, 0), b2, voffB);
            G_BAR; G_WAIT_L(0); G_MMA(0, 1, At, B1); G_BAR;
            G_LDA(At, 0, 1); G_STAGE(G_SA(0, 0), a2, voffA);
            G_BAR; G_WAIT_L(0); G_MMA(1, 0, At, B0); G_BAR; G_SCHED;
            G_STAGE(G_SB(0, 1), b2 + hstepB, voffB);
            G_WAIT_V(6); G_BAR; G_MMA(1, 1, At, B1); G_BAR;
            G_LDB(B0, 1, 0); G_SCHED; G_LDA(At, 1, 0); G_STAGE(G_SA(0, 1), a2 + hstepA, voffA);
            G_WAIT_L(8); G_BAR; G_WAIT_L(0); G_MMA(0, 0, At, B0); G_BAR; G_SCHED;
            G_LDB(B1, 1, 1); G_STAGE(G_SB(1, 0), b3, voffB);
            G_BAR; G_WAIT_L(0); G_MMA(0, 1, At, B1); G_BAR;
            G_LDA(At, 1, 1); G_STAGE(G_SA(1, 0), a3, voffA);
            G_BAR; G_WAIT_L(0); G_MMA(1, 0, At, B0); G_BAR; G_SCHED;
            G_STAGE(G_SB(1, 1), b3 + hstepB, voffB);
            G_WAIT_V(6); G_BAR; G_MMA(1, 1, At, B1); G_BAR;
        }
        if constexpr (MODE == 1) asm volatile("s_nop 15\n\ts_nop 15" ::: "memory");
        const bool zero = E(acc, cur, wr, wc, fr, fq);
        if (!has_next) break;
        if (zero) {
#pragma unroll
            for (int a = 0; a < 2; ++a)
#pragma unroll
                for (int b = 0; b < 2; ++b)
#pragma unroll
                    for (int m = 0; m < 4; ++m)
#pragma unroll
                        for (int n = 0; n < 2; ++n) acc[a][b][m][n] = (f32x4){0.f, 0.f, 0.f, 0.f};
        }
        cur = nxt; cA = nA; cB = nB; ++ui;
    }
    G_WAIT_V(0);
    if (wr == 0) G_BAR;
    G_BAR;
#undef G_SA
#undef G_SB
#undef G_STAGE
#undef G_LDA
#undef G_LDB
#undef G_MMA
#undef G_WAIT_V
#undef G_WAIT_L
#undef G_BAR
#undef G_SCHED
}

struct Sched1a {
    int G, c;
    __device__ __forceinline__ bool next(int i, Unit& u) const {
        int L = i * G + c; u.kh = 0; u.type = 0;
        if (L < 48) { u.pm = L >> 2; u.pn = 40 + (L & 3); return true; }
        L -= 48; if (L >= 8) return false;
        u.pm = 0; u.pn = 8 + L; u.type = 1; return true;
    }
};
struct Sched1c {
    int G, c;
    __device__ __forceinline__ bool next(int i, Unit& u) const { const int L = i * G + (G - 1 - c); if (L >= 3264) return false; tile_map(L, 136, 24, u.pm, u.pn); u.pn += 4;     u.kh = 0; u.type = 0; return true; }
};
struct Sched1b {
    int G, c;
    __device__ __forceinline__ bool next(int i, Unit& u) const { const int L = i * G + (G - 1 - c); if (L >= 2176) return false; tile_map(L, 136, 16, u.pm, u.pn); u.pn += 24; u.kh = 0; u.type = 0; return true; }
};
struct SchedA {
    int G, c;
    __device__ __forceinline__ bool next(int i, Unit& u) const { const int L = (i >> 1) * G + c; if (L >= 1024) return false; tile_map(L, 128, 8, u.pm, u.pn); u.kh = i & 1; u.type = 0; return true; }
};
struct SchedB {
    int G, c;
    __device__ __forceinline__ bool next(int i, Unit& u) const { const int L = (i >> 1) * G + c; if (L >= 1024) return false; u.kh = i & 1;
        if (L < 960) { tile_map(L, 120, 8, u.pm, u.pn); u.type = 1; } else { tile_map(L - 960, 8, 8, u.pm, u.pn); u.pm += 128; u.type = 0; }
        return true; }
};
struct SchedC {
    int G, c;
    __device__ __forceinline__ bool next(int i, Unit& u) const { const int L = (i >> 1) * G + c; if (L >= 128) return false; tile_map(L, 16, 8, u.pm, u.pn); u.pm += 120; u.kh = i & 1; u.type = 1; return true; }
};

struct Epi1 {
    bf16_t *XM, *SA, *U, *G2; float* out;
    __device__ __forceinline__ bool operator()(f32x4 (&acc)[2][2][4][2], const Unit& u, int wr, int wc, int fr, int fq) const {
        const int pn = u.pn, pmr = pn >= 40 ? (u.pm < 4 ? u.pm * 32 + 31 : 124 + u.pm) : u.pm, r0 = pmr * BM + wr * 64 + fr, cl = wc * 32 + fq * 8;
        if (pn < 8) {
            bf16_t* O = pn < 4 ? XM : SA; const bool act = pn >= 4; const int c0 = (pn & 3) * 256 + cl;
#pragma unroll
            for (int ai = 0; ai < 2; ++ai)
#pragma unroll
                for (int m = 0; m < 4; ++m) { bf16_t* rowp = O + (size_t)(r0 + ai * HALF + m * 16) * 1024 + c0;
#pragma unroll
                    for (int bj = 0; bj < 2; ++bj) { f32x4 v0 = acc[ai][bj][m][0], v1 = acc[ai][bj][m][1];
                        if (act) {
#pragma unroll
                            for (int j = 0; j < 4; ++j) { v0[j] = silu_f(v0[j]); v1[j] = silu_f(v1[j]); } }
                        u32x4 w; w.x = pk_bf16(v0[0], v0[1]); w.y = pk_bf16(v0[2], v0[3]); w.z = pk_bf16(v1[0], v1[1]); w.w = pk_bf16(v1[2], v1[3]);
                        *(u32x4*)(rowp + bj * HALF) = w; } }
        } else if (pn < 24) {
            const bool isvc = pn < 16; bf16_t* O = isvc ? U : G2; const int ch0 = ((pn - 8) & 7) * 128 + cl;
#pragma unroll
            for (int ai = 0; ai < 2; ++ai)
#pragma unroll
                for (int m = 0; m < 4; ++m) { const int row = r0 + ai * HALF + m * 16;
                    f32x4 v0, v1; const f32x4 a0 = acc[ai][0][m][0], a1 = acc[ai][0][m][1], b0 = acc[ai][1][m][0], b1 = acc[ai][1][m][1];
                    if (isvc) { v0 = a0 * b0; v1 = a1 * b1; }
                    else {
#pragma unroll
                        for (int j = 0; j < 4; ++j) { v0[j] = a0[j] * silu_f(b0[j]); v1[j] = a1[j] * silu_f(b1[j]); } }
                    u32x4 w; w.x = pk_bf16(v0[0], v0[1]); w.y = pk_bf16(v0[2], v0[3]); w.z = pk_bf16(v1[0], v1[1]); w.w = pk_bf16(v1[2], v1[3]);
                    if (u.type == 1) {
                        if (row < 72) { float* dst = (row < 8 ? out + O_NCP + (size_t)row * 1024 : out + O_NCS + (size_t)(row - 8) * 1024) + ch0; *(f32x4*)dst = v0; *(f32x4*)(dst + 4) = v1; } }
                    else *(u32x4*)(O + (size_t)row * 1024 + ch0) = w; }
        } else {
            const bool samp = pmr >= 128; const int c0 = (pn - 40) * 256 + cl;
            if (fr >= 1) {
#pragma unroll
                for (int ai = 0; ai < 2; ++ai) {
                    if (samp || (ai == 1 && wr == 1)) { const int row = r0 + ai * HALF + 48;
                        float* dst = samp ? out + O_NPS + ((size_t)((row - TP) >> 6) * 15 + (fr - 1)) * 1024 + c0 : out + O_NPP + ((size_t)(row >> 13) * 15 + (fr - 1)) * 1024 + c0;
#pragma unroll
                        for (int bj = 0; bj < 2; ++bj) { *(f32x4*)(dst + bj * HALF) = acc[ai][bj][3][0]; *(f32x4*)(dst + bj * HALF + 4) = acc[ai][bj][3][1]; } } }
            }
        }
        return true;
    }
};

struct EpiI8 {
    bf16_t *SA, *U, *G2; const float* rsc; const float* csv;
    __device__ __forceinline__ bool operator()(f32x4 (&acc)[2][2][4][2], const Unit& u, int wr, int wc, int fr, int fq) const {
        const int pn = u.pn, r0 = u.pm * BM + wr * 64 + fr, cl = wc * 32 + fq * 8;
        const float* cq = csv + (pn - 4) * 256 + cl;
        const f32x4 c00 = *(const f32x4*)(cq), c01 = *(const f32x4*)(cq + 4), c10 = *(const f32x4*)(cq + HALF), c11 = *(const f32x4*)(cq + HALF + 4);
        const int kind = pn < 8 ? 0 : (pn < 16 ? 1 : (pn < 24 ? 2 : 3));
        bf16_t* O = SA + (ptrdiff_t)(kind == 3 ? -1 : kind) * ((ptrdiff_t)T * 1024);
        const int c0 = (kind == 0 || kind == 3) ? (pn & 3) * 256 + cl : ((pn - 8) & 7) * 128 + cl;
#pragma unroll
        for (int ai = 0; ai < 2; ++ai)
#pragma unroll
            for (int m = 0; m < 4; ++m) { const int row = r0 + ai * HALF + m * 16; const float rq = rsc[row];
                const i32x4 i00 = __builtin_bit_cast(i32x4, acc[ai][0][m][0]), i01 = __builtin_bit_cast(i32x4, acc[ai][0][m][1]), i10 = __builtin_bit_cast(i32x4, acc[ai][1][m][0]), i11 = __builtin_bit_cast(i32x4, acc[ai][1][m][1]);
                f32x4 a0, a1, b0, b1;
#pragma unroll
                for (int j = 0; j < 4; ++j) { a0[j] = (float)i00[j] * (rq * c00[j]); a1[j] = (float)i01[j] * (rq * c01[j]); b0[j] = (float)i10[j] * (rq * c10[j]); b1[j] = (float)i11[j] * (rq * c11[j]); }
                if (kind == 0 || kind == 3) {
                    if (kind == 0) {
#pragma unroll
                        for (int j = 0; j < 4; ++j) { a0[j] = silu_f(a0[j]); a1[j] = silu_f(a1[j]); b0[j] = silu_f(b0[j]); b1[j] = silu_f(b1[j]); } }
                    u32x4 w; w.x = pk_bf16(a0[0], a0[1]); w.y = pk_bf16(a0[2], a0[3]); w.z = pk_bf16(a1[0], a1[1]); w.w = pk_bf16(a1[2], a1[3]);
                    *(u32x4*)(O + (size_t)row * 1024 + c0) = w;
                    w.x = pk_bf16(b0[0], b0[1]); w.y = pk_bf16(b0[2], b0[3]); w.z = pk_bf16(b1[0], b1[1]); w.w = pk_bf16(b1[2], b1[3]);
                    *(u32x4*)(O + (size_t)row * 1024 + c0 + HALF) = w;
                } else { f32x4 v0, v1;
                    if (kind == 1) { v0 = a0 * b0; v1 = a1 * b1; }
                    else {
#pragma unroll
                        for (int j = 0; j < 4; ++j) { v0[j] = a0[j] * silu_f(b0[j]); v1[j] = a1[j] * silu_f(b1[j]); } }
                    u32x4 w; w.x = pk_bf16(v0[0], v0[1]); w.y = pk_bf16(v0[2], v0[3]); w.z = pk_bf16(v1[0], v1[1]); w.w = pk_bf16(v1[2], v1[3]);
                    *(u32x4*)(O + (size_t)row * 1024 + c0) = w; } }
        return true;
    }
};
struct EpiGG {
    bf16_t *SGR, *SGB; const float* bgate; float gsc;
    __device__ __forceinline__ bool operator()(f32x4 (&acc)[2][2][4][2], const Unit& u, int wr, int wc, int fr, int fq) const {
        const int pn = u.pn, r0 = u.pm * BM + wr * 64 + fr, cl = wc * 32 + fq * 8;
        {
            const int ch0 = (pn - 24) * 128 + cl;
            const f32x4 ba0 = *(const f32x4*)(bgate + ch0), ba1 = *(const f32x4*)(bgate + ch0 + 4), bb0 = *(const f32x4*)(bgate + D + ch0), bb1 = *(const f32x4*)(bgate + D + ch0 + 4);
#pragma unroll
            for (int ai = 0; ai < 2; ++ai)
#pragma unroll
                for (int m = 0; m < 4; ++m) { const int row = r0 + ai * HALF + m * 16;
                    const f32x4 a0 = acc[ai][0][m][0] * gsc + ba0, a1 = acc[ai][0][m][1] * gsc + ba1, b0 = acc[ai][1][m][0] * gsc + bb0, b1 = acc[ai][1][m][1] * gsc + bb1;
                    f32x4 r0v, r1v, s0v, s1v;
#pragma unroll
                    for (int j = 0; j < 4; ++j) {
                        const float ea0 = __builtin_amdgcn_exp2f(-1.44269504f * fminf(fmaxf(a0[j], -40.f), 40.f)), eb0 = __builtin_amdgcn_exp2f(-1.44269504f * fminf(fmaxf(b0[j], -40.f), 40.f));
                        const float ea1 = __builtin_amdgcn_exp2f(-1.44269504f * fminf(fmaxf(a1[j], -40.f), 40.f)), eb1 = __builtin_amdgcn_exp2f(-1.44269504f * fminf(fmaxf(b1[j], -40.f), 40.f));
                        s0v[j] = __builtin_amdgcn_rcpf(1.0f + eb0); s1v[j] = __builtin_amdgcn_rcpf(1.0f + eb1);
                        r0v[j] = (1.0f + eb0) * __builtin_amdgcn_rcpf(1.0f + ea0); r1v[j] = (1.0f + eb1) * __builtin_amdgcn_rcpf(1.0f + ea1); }
                    u32x4 w; w.x = pk_bf16(r0v[0], r0v[1]); w.y = pk_bf16(r0v[2], r0v[3]); w.z = pk_bf16(r1v[0], r1v[1]); w.w = pk_bf16(r1v[2], r1v[3]);
                    *(u32x4*)(SGR + (size_t)row * D + ch0) = w;
                    w.x = pk_bf16(s0v[0], s0v[1]); w.y = pk_bf16(s0v[2], s0v[3]); w.z = pk_bf16(s1v[0], s1v[1]); w.w = pk_bf16(s1v[2], s1v[3]);
                    *(u32x4*)(SGB + (size_t)row * D + ch0) = w; }
        }
        return true;
    }
};

struct EpiD {
    const bf16_t *SGR, *SGB; bf16_t* MG;
    __device__ __forceinline__ bool operator()(f32x4 (&acc)[2][2][4][2], const Unit& u, int wr, int wc, int fr, int fq) const {
        const int r0 = u.pm * BM + wr * 64 + fr, c0 = u.pn * BM + wc * 32 + fq * 8;
        const bf16_t* S = u.kh ? SGB : SGR;
#pragma unroll
        for (int ai = 0; ai < 2; ++ai)
#pragma unroll
            for (int m = 0; m < 4; ++m) { const size_t off = (size_t)(r0 + ai * HALF + m * 16) * D + c0;
#pragma unroll
                for (int bj = 0; bj < 2; ++bj) { const u32x4 s = *(const u32x4*)(S + off + bj * HALF);
                    f32x4 v0 = acc[ai][bj][m][0], v1 = acc[ai][bj][m][1];
                    v0[0] *= bf_lo(s.x); v0[1] *= bf_hi(s.x); v0[2] *= bf_lo(s.y); v0[3] *= bf_hi(s.y);
                    v1[0] *= bf_lo(s.z); v1[1] *= bf_hi(s.z); v1[2] *= bf_lo(s.w); v1[3] *= bf_hi(s.w);
                    acc[ai][bj][m][0] = v0; acc[ai][bj][m][1] = v1; } }
        if (u.kh == 0) return false;
#pragma unroll
        for (int ai = 0; ai < 2; ++ai)
#pragma unroll
            for (int m = 0; m < 4; ++m) { const size_t off = (size_t)(r0 + ai * HALF + m * 16) * LDP + c0;
#pragma unroll
                for (int bj = 0; bj < 2; ++bj) { const f32x4 v0 = acc[ai][bj][m][0], v1 = acc[ai][bj][m][1];
                    u32x4 w; w.x = pk_bf16(v0[0], v0[1]); w.y = pk_bf16(v0[2], v0[3]); w.z = pk_bf16(v1[0], v1[1]); w.w = pk_bf16(v1[2], v1[3]);
                    *(u32x4*)(MG + off + bj * HALF) = w; } }
        return true;
    }
};

struct EpiE {
    bf16_t* DL;
    __device__ __forceinline__ bool operator()(f32x4 (&acc)[2][2][4][2], const Unit& u, int wr, int wc, int fr, int fq) const {
        const int r0 = u.pm * BM + wr * 64 + fr, c0 = u.pn * BM + wc * 32 + fq * 8;
#pragma unroll
        for (int ai = 0; ai < 2; ++ai)
#pragma unroll
            for (int m = 0; m < 4; ++m) { bf16_t* rowp = DL + (size_t)(r0 + ai * HALF + m * 16) * LDP + c0;
#pragma unroll
                for (int bj = 0; bj < 2; ++bj) { const f32x4 v0 = acc[ai][bj][m][0], v1 = acc[ai][bj][m][1];
                    u32x4 w; w.x = pk_bf16(v0[0], v0[1]); w.y = pk_bf16(v0[2], v0[3]); w.z = pk_bf16(v1[0], v1[1]); w.w = pk_bf16(v1[2], v1[3]);
                    *(u32x4*)(rowp + bj * HALF) = w; } }
        return true;
    }
};

struct EpiMix {
    EpiD d; EpiE e;
    __device__ __forceinline__ bool operator()(f32x4 (&acc)[2][2][4][2], const Unit& u, int wr, int wc, int fr, int fq) const {
        if (u.type == 0) return d(acc, u, wr, wc, fr, fq);
        if (u.kh == 0) return false;
        return e(acc, u, wr, wc, fr, fq);
    }
};

struct TrJob { const float* src; bf16_t* dst; int sld; unsigned char* dst8; unsigned char* dst8i; const float* cm; float* csv; int wr16; };
__device__ __forceinline__ int win_srccol(int vch) {
    const int pn = vch >> 2, q = vch & 3, bj = q >> 1, cl0 = (q & 1) * 64;
    if (pn < 8) return 1024 + 256 * (pn - 4) + q * 64;
    if (pn < 16) return (bj ? 4096 : 2048) + 128 * (pn - 8) + cl0;
    if (pn < 24) return (bj ? 5120 : 3072) + 128 * (pn - 16) + cl0;
    if (pn < 40) return (bj ? 8192 : 6144) + 128 * (pn - 24) + cl0;
    return 256 * (pn - 40) + q * 64;
}
__device__ __forceinline__ TrJob tr_job(const Params& p, int j) {
    TrJob t;
    t.dst8 = nullptr; t.dst8i = nullptr; t.cm = nullptr; t.csv = nullptr; t.wr16 = 1;
    if (j < 5120) { const int vch = 16 + (j >> 5), kc = j & 31; t.src = p.win + (size_t)(kc * 64) * NIN + win_srccol(vch); t.sld = NIN; t.dst = (bf16_t*)(p.ws + WS_BIN) + (size_t)(vch * 64) * LDP + kc * 64;
        if (vch >= 96 && vch < 160) { t.dst8 = p.ws + WS_BIN8 + (size_t)((vch - 96) * 64) * LD8 + kc * 64; t.wr16 = 0; }
        if (vch < 96) { t.dst8i = p.ws + WS_BIN8I + (size_t)((vch - 16) * 64) * LD8 + kc * 64; t.cm = (const float*)(p.ws + WS_CMAX) + win_srccol(vch);
            if (kc == 0) t.csv = (float*)(p.ws + WS_CSV) + (vch - 16) * 64;
            t.wr16 = (vch >= 32 && vch < 64) ? 1 : 0; } }
    else if (j < 6144) { const int jj = j - 5120, nc = jj >> 5, kc = jj & 31;
        t.src = (kc < 16 ? p.wpp + (size_t)(kc * 64) * D : p.wpc + (size_t)((kc - 16) * 64) * D) + nc * 64; t.sld = D; t.dst = (bf16_t*)(p.ws + WS_BP) + (size_t)(nc * 64) * LDP + kc * 64; }
    else { const int jj = j - 6144, nc = jj >> 5, kc = jj & 31; t.src = p.wout + (size_t)(kc * 64) * D + nc * 64; t.sld = D; t.dst = (bf16_t*)(p.ws + WS_BO) + (size_t)(nc * 64) * LDP + kc * 64; }
    return t;
}
__device__ __forceinline__ void tr_load4(const Params& p, int j0, int tid, f32x4 (&v)[4][2]) {
#pragma unroll
    for (int q = 0; q < 4; ++q) { const TrJob t = tr_job(p, j0 + q);
#pragma unroll
        for (int i = 0; i < 2; ++i) { const int idx = tid + i * 512, kr = idx >> 4, c4 = idx & 15; v[q][i] = *(const f32x4*)(t.src + (size_t)kr * t.sld + c4 * 4); } }
}
__device__ __forceinline__ void tr_all(const Params& p, LAS float* sm, int b, int G, int tid) {
    f32x4 v[4][2];
    int jb = b;
    if (jb < 1792) tr_load4(p, jb * 4, tid, v);
    while (jb < 1792) {
#pragma unroll
        for (int q = 0; q < 4; ++q)
#pragma unroll
            for (int i = 0; i < 2; ++i) { const int idx = tid + i * 512, kr = idx >> 4, c4 = idx & 15; LAS float* d = sm + q * 4160 + kr * 65 + c4 * 4; d[0] = v[q][i][0]; d[1] = v[q][i][1]; d[2] = v[q][i][2]; d[3] = v[q][i][3]; }
        __syncthreads();
        const int nb = jb + G;
        if (nb < 1792) tr_load4(p, nb * 4, tid, v);
        const int kg = tid & 7, c = tid >> 3;
#pragma unroll 1
        for (int q = 0; q < 4; ++q) { const TrJob t = tr_job(p, jb * 4 + q);
            float f[8];
#pragma unroll
            for (int i = 0; i < 8; ++i) f[i] = sm[q * 4160 + (kg * 8 + i) * 65 + c];
            if (t.dst8) { u32x2 w8; w8.x = pk_fp8x4(f[0] * W8_SCALE, f[1] * W8_SCALE, f[2] * W8_SCALE, f[3] * W8_SCALE); w8.y = pk_fp8x4(f[4] * W8_SCALE, f[5] * W8_SCALE, f[6] * W8_SCALE, f[7] * W8_SCALE);
                *(u32x2*)(t.dst8 + (size_t)c * LD8 + kg * 8) = w8; }
            if (t.dst8i) { const float cmx = t.cm[c], sc = cmx > 0.f ? 127.0f / cmx : 0.f;
                u32x2 w8; w8.x = pk_i8x4(f[0] * sc, f[1] * sc, f[2] * sc, f[3] * sc); w8.y = pk_i8x4(f[4] * sc, f[5] * sc, f[6] * sc, f[7] * sc);
                *(u32x2*)(t.dst8i + (size_t)c * LD8 + kg * 8) = w8;
                if (t.csv && kg == 0) t.csv[c] = cmx * (1.0f / 127.0f); }
            if (t.wr16) { u32x4 w; w.x = pk_bf16(f[0], f[1]); w.y = pk_bf16(f[2], f[3]); w.z = pk_bf16(f[4], f[5]); w.w = pk_bf16(f[6], f[7]);
                *(u32x4*)(t.dst + (size_t)c * LDP + kg * 8) = w; } }
        __syncthreads();
        jb = nb;
    }
}

template <bool TRANS>
__device__ __forceinline__ void mm_tile(LAS float* sm, int tid, const float* __restrict__ A, int lda, int r0, int rmax, int acol0, const float* __restrict__ Wm, int d0, void* dstv, int ldd, int n0, unsigned* cmaxw) {
    LAS float* As = sm; LAS float* Bt = sm + 64 * 68;
    const int lane = tid & 63, w = tid >> 6, fr = lane & 15, fq = lane >> 4, br = w >> 1, bc0 = (w & 1) * 2;
    f32x4 acc0 = (f32x4){0.f, 0.f, 0.f, 0.f}, acc1 = (f32x4){0.f, 0.f, 0.f, 0.f};
    f32x4 va[2], vb[2];
#pragma unroll
    for (int i = 0; i < 2; ++i) { const int idx = tid + i * 512, rr = idx >> 4, c4 = idx & 15;
        va[i] = (f32x4){0.f, 0.f, 0.f, 0.f}; if (r0 + rr < rmax) va[i] = *(const f32x4*)(A + (size_t)(r0 + rr) * lda + acol0 + c4 * 4);
        vb[i] = *(const f32x4*)(Wm + (size_t)rr * 256 + d0 + c4 * 4); }
    for (int cc = 0; cc < 256; cc += 64) {
#pragma unroll
        for (int i = 0; i < 2; ++i) { const int idx = tid + i * 512, rr = idx >> 4, c4 = idx & 15;
            *(LAS f32x4*)(As + rr * 68 + c4 * 4) = va[i];
            LAS float* q = Bt + (c4 * 4) * 68 + rr; q[0] = vb[i][0]; q[68] = vb[i][1]; q[136] = vb[i][2]; q[204] = vb[i][3]; }
        __syncthreads();
        if (cc + 64 < 256) {
#pragma unroll
            for (int i = 0; i < 2; ++i) { const int idx = tid + i * 512, rr = idx >> 4, c4 = idx & 15;
                va[i] = (f32x4){0.f, 0.f, 0.f, 0.f}; if (r0 + rr < rmax) va[i] = *(const f32x4*)(A + (size_t)(r0 + rr) * lda + acol0 + cc + 64 + c4 * 4);
                vb[i] = *(const f32x4*)(Wm + (size_t)(cc + 64 + rr) * 256 + d0 + c4 * 4); } }
#pragma unroll
        for (int ks = 0; ks < 2; ++ks) {
            const LAS float* ap = As + (br * 16 + fr) * 68 + ks * 32 + fq * 8;
            const f32x4 a0 = *(const LAS f32x4*)ap, a1 = *(const LAS f32x4*)(ap + 4);
            u32x4 aw; aw.x = pk_bf16(a0[0], a0[1]); aw.y = pk_bf16(a0[2], a0[3]); aw.z = pk_bf16(a1[0], a1[1]); aw.w = pk_bf16(a1[2], a1[3]);
            const bf16x8 af = __builtin_bit_cast(bf16x8, aw);
#pragma unroll
            for (int bb = 0; bb < 2; ++bb) {
                const LAS float* bp = Bt + ((bc0 + bb) * 16 + fr) * 68 + ks * 32 + fq * 8;
                const f32x4 b0 = *(const LAS f32x4*)bp, b1 = *(const LAS f32x4*)(bp + 4);
                u32x4 bw; bw.x = pk_bf16(b0[0], b0[1]); bw.y = pk_bf16(b0[2], b0[3]); bw.z = pk_bf16(b1[0], b1[1]); bw.w = pk_bf16(b1[2], b1[3]);
                const bf16x8 bf = __builtin_bit_cast(bf16x8, bw);
                if (bb == 0) acc0 = __builtin_amdgcn_mfma_f32_16x16x32_bf16(af, bf, acc0, 0, 0, 0);
                else acc1 = __builtin_amdgcn_mfma_f32_16x16x32_bf16(af, bf, acc1, 0, 0, 0);
            }
        }
        __syncthreads();
    }
#pragma unroll
    for (int bb = 0; bb < 2; ++bb) { const f32x4 cacc = bb ? acc1 : acc0; const int d = (bc0 + bb) * 16 + fr, rl = br * 16 + fq * 4;
        if (TRANS) { bf16_t* dst = (bf16_t*)dstv; u32x2 wv; wv.x = pk_bf16(cacc[0], cacc[1]); wv.y = pk_bf16(cacc[2], cacc[3]);
            *(u32x2*)(dst + (size_t)(n0 + d) * ldd + r0 + rl) = wv;
            float mx = fmaxf(fmaxf(fabsf(cacc[0]), fabsf(cacc[1])), fmaxf(fabsf(cacc[2]), fabsf(cacc[3])));
            mx = fmaxf(mx, __shfl_xor(mx, 16)); mx = fmaxf(mx, __shfl_xor(mx, 32));
            if (fq == 0 && cmaxw) atomicMax(cmaxw + n0 + d, __float_as_uint(mx)); }
        else { float* dst = (float*)dstv;
#pragma unroll
            for (int e = 0; e < 4; ++e) if (r0 + rl + e < rmax) dst[(size_t)(r0 + rl + e) * ldd + n0 + d] = cacc[e]; } }
}
template <int NR>
__device__ __forceinline__ void p0_rows(const Params& p, int r, int nw, int lane) {
    bf16_t* H = (bf16_t*)(p.ws + WS_H);
    f32x4 v[NR][8];
#pragma unroll
    for (int k = 0; k < NR; ++k) { const int row = r + k * nw; const float* x = row < TP ? p.xp + (size_t)row * D : p.xs + (size_t)(row - TP) * D;
#pragma unroll
        for (int i = 0; i < 4; ++i) { v[k][2 * i] = *(const f32x4*)(x + (i * 64 + lane) * 8); v[k][2 * i + 1] = *(const f32x4*)(x + (i * 64 + lane) * 8 + 4); } }
#pragma unroll
    for (int k = 0; k < NR; ++k) { const int row = r + k * nw; float ss = 0.f;
#pragma unroll
        for (int i = 0; i < 8; ++i) ss += (v[k][i][0] * v[k][i][0] + v[k][i][1] * v[k][i][1]) + (v[k][i][2] * v[k][i][2] + v[k][i][3] * v[k][i][3]);
#pragma unroll
        for (int o = 32; o >= 1; o >>= 1) ss += __shfl_xor(ss, o);
        const float rs = rsqrtf(ss * (1.0f / D) + EPS);
        float amax = 0.f;
#pragma unroll
        for (int i = 0; i < 4; ++i) { const f32x4 g0 = *(const f32x4*)(p.ng + (i * 64 + lane) * 8), g1 = *(const f32x4*)(p.ng + (i * 64 + lane) * 8 + 4);
            v[k][2 * i] = v[k][2 * i] * rs * g0; v[k][2 * i + 1] = v[k][2 * i + 1] * rs * g1;
#pragma unroll
            for (int j = 0; j < 4; ++j) amax = fmaxf(amax, fmaxf(fabsf(v[k][2 * i][j]), fabsf(v[k][2 * i + 1][j]))); }
#pragma unroll
        for (int o = 32; o >= 1; o >>= 1) amax = fmaxf(amax, __shfl_xor(amax, o));
        const float qs = amax > 0.f ? 127.0f / amax : 0.f;
        if (lane == 0) ((float*)(p.ws + WS_RSC))[row] = amax * (1.0f / 127.0f);
        int gidx = -1; const int pmr = row >> 8; const bool need16 = pmr >= 128 || (pmr & 31) == 31; const int xe = pmr >= 128 ? pmr - 124 : pmr >> 5;
        if (row < TP) { const int pos = row & 8191; if (pos >= 8190) gidx = (row >> 13) * 2 + (pos - 8190); }
        else { const int rsq = row - TP, pos = rsq & 63; if (pos >= 62) gidx = 8 + (rsq >> 6) * 2 + (pos - 62); }
#pragma unroll
        for (int i = 0; i < 4; ++i) { const f32x4 a = v[k][2 * i], c = v[k][2 * i + 1];
            u32x4 w; w.x = pk_bf16(a[0], a[1]); w.y = pk_bf16(a[2], a[3]); w.z = pk_bf16(c[0], c[1]); w.w = pk_bf16(c[2], c[3]);
            if (need16) *(u32x4*)((bf16_t*)(p.ws + WS_HX) + (size_t)(xe * 256 + (row & 255)) * LDP + (i * 64 + lane) * 8) = w;
            u32x2 w8; w8.x = pk_fp8x4(a[0], a[1], a[2], a[3]); w8.y = pk_fp8x4(c[0], c[1], c[2], c[3]);
            *(u32x2*)(p.ws + WS_H8 + (size_t)row * LD8 + (i * 64 + lane) * 8) = w8;
            u32x2 wi; wi.x = pk_i8x4(a[0] * qs, a[1] * qs, a[2] * qs, a[3] * qs); wi.y = pk_i8x4(c[0] * qs, c[1] * qs, c[2] * qs, c[3] * qs);
            *(u32x2*)(p.ws + WS_H8I + (size_t)row * LD8 + (i * 64 + lane) * 8) = wi;
            if (gidx >= 0) *(u32x4*)((bf16_t*)(p.ws + WS_HG) + (size_t)gidx * LDP + (i * 64 + lane) * 8) = w; } }
}

__device__ __forceinline__ void phase_colmax(const Params& p, LAS unsigned char* lds) {
    LAS f32x4* red = (LAS f32x4*)lds;
    unsigned* cm = (unsigned*)(p.ws + WS_CMAX);
    const int t = threadIdx.x, cq = t % 80, sg = t / 80;
    for (int blk = blockIdx.x; blk < 256; blk += gridDim.x) {
        const int rg = blk >> 4, cb = blk & 15, col = 1024 + cb * 320 + cq * 4;
        f32x4 m = (f32x4){0.f, 0.f, 0.f, 0.f};
        if (sg < 6) for (int r = rg * 128 + sg; r < rg * 128 + 128; r += 6) { const f32x4 v = *(const f32x4*)(p.win + (size_t)r * NIN + col);
            m[0] = fmaxf(m[0], fabsf(v[0])); m[1] = fmaxf(m[1], fabsf(v[1])); m[2] = fmaxf(m[2], fabsf(v[2])); m[3] = fmaxf(m[3], fabsf(v[3])); }
        if (sg < 6) red[sg * 80 + cq] = m;
        __syncthreads();
        if (sg == 0) {
#pragma unroll
            for (int k = 1; k < 6; ++k) { const f32x4 o = red[k * 80 + cq]; m[0] = fmaxf(m[0], o[0]); m[1] = fmaxf(m[1], o[1]); m[2] = fmaxf(m[2], o[2]); m[3] = fmaxf(m[3], o[3]); }
#pragma unroll
            for (int j = 0; j < 4; ++j) atomicMax(cm + col + j, __float_as_uint(m[j]));
        }
        __syncthreads();
    }
    { int t2 = threadIdx.x; asm volatile("" : "+v"(t2));
      for (int j = blockIdx.x; j < 512; j += gridDim.x) { const int kc = j >> 4, dc = j & 15, g = dc >> 2, d0 = (dc & 3) * 64;
        mm_tile<true>((LAS float*)lds, t2, p.win, NIN, kc * 64, 2048, g * 256, p.wmix + (size_t)g * 65536, d0, (bf16_t*)(p.ws + WS_BIN), LDP, g * 256 + d0, (unsigned*)(p.ws + WS_CMAXW)); } }
    if (blockIdx.x == 0) { u32x4 z = (u32x4){0u, 0u, 0u, 0u}; u32x4* hg = (u32x4*)(p.ws + WS_HG + (size_t)72 * LDP * 2);
        for (int i = threadIdx.x; i < (256 - 72) * LDP * 2 / 16; i += NTHREADS) hg[i] = z; }
}

__device__ __forceinline__ void phase0(const Params& p, LAS unsigned char* lds) {
    LAS float* sm = (LAS float*)lds;
    int t_ = threadIdx.x; asm volatile("" : "+v"(t_));
    const int G = gridDim.x, b = blockIdx.x, tid = t_, lane = tid & 63, wid = tid >> 6;
    bf16_t* BIN = (bf16_t*)(p.ws + WS_BIN);
    for (int d = b * 8 + wid; d < 1024; d += G * 8) {
        const float cmx = ((const float*)(p.ws + WS_CMAXW))[d], sc = cmx > 0.f ? 127.0f / cmx : 0.f;
        const u32x4* src = (const u32x4*)(BIN + (size_t)d * LDP + lane * 32);
        u32x4 o[2];
#pragma unroll
        for (int h = 0; h < 2; ++h) { const u32x4 w0 = src[2 * h], w1 = src[2 * h + 1];
            o[h].x = pk_i8x4(bf_lo(w0.x) * sc, bf_hi(w0.x) * sc, bf_lo(w0.y) * sc, bf_hi(w0.y) * sc); o[h].y = pk_i8x4(bf_lo(w0.z) * sc, bf_hi(w0.z) * sc, bf_lo(w0.w) * sc, bf_hi(w0.w) * sc);
            o[h].z = pk_i8x4(bf_lo(w1.x) * sc, bf_hi(w1.x) * sc, bf_lo(w1.y) * sc, bf_hi(w1.y) * sc); o[h].w = pk_i8x4(bf_lo(w1.z) * sc, bf_hi(w1.z) * sc, bf_lo(w1.w) * sc, bf_hi(w1.w) * sc); }
        u32x4* dst = (u32x4*)(p.ws + WS_BIN8I + (size_t)(5120 + d) * LD8 + lane * 32);
        dst[0] = o[0]; dst[1] = o[1];
        if (lane == 0) ((float*)(p.ws + WS_CSV))[5120 + d] = cmx * (1.0f / 127.0f);
    }
    for (int j = b; j < 128; j += G) { const int rc = j >> 4, dc = j & 15, g = dc >> 2, d0 = (dc & 3) * 64;
        mm_tile<false>(sm, tid, p.spool, 1024, rc * 64, 480, g * 256, p.wmix + (size_t)g * 65536, d0, (float*)(p.ws + WS_BUFM), 1024, g * 256 + d0, nullptr); }
    tr_all(p, sm, b, G, tid);
    const int gw = b * 8 + wid, nw = G * 8;
    int r = gw;
    for (; r + nw < T; r += 2 * nw) p0_rows<2>(p, r, nw, lane);
    if (r < T) p0_rows<1>(p, r, nw, lane);
}

template <bool SAMPLE>
__device__ __forceinline__ void stencil_run(const Params& p, int seq, int t0, int nT, int c0) {
    const bf16_t* __restrict__ XM = (const bf16_t*)(p.ws + WS_XM); const bf16_t* __restrict__ SA = (const bf16_t*)(p.ws + WS_SA);
    const bf16_t* __restrict__ U = (const bf16_t*)(p.ws + WS_U); const bf16_t* __restrict__ G2 = (const bf16_t*)(p.ws + WS_G2);
    const float* __restrict__ BUFM = (const float*)(p.ws + WS_BUFM);
    bf16_t* __restrict__ YC = (bf16_t*)(p.ws + WS_H);
    const int rowbase = SAMPLE ? TP + seq * 64 : seq * 8192;
    const int w = 2 << (c0 >> 8);
    float sp[8], um1[8], um2[8], sc[8], w0[8], w1[8], w2[8];
#pragma unroll
    for (int j = 0; j < 8; ++j) { sp[j] = 0.f; sc[j] = p.pscale[c0 + j]; w0[j] = p.wconv[c0 + j]; w1[j] = p.wconv[1024 + c0 + j]; w2[j] = p.wconv[2048 + c0 + j]; }
    for (int i = 1; i < w; ++i) { const int t = t0 - i;
        if (t >= 0) { const u32x4 v = *(const u32x4*)(XM + (size_t)(rowbase + t) * 1024 + c0);
            sp[0] += bf_lo(v.x); sp[1] += bf_hi(v.x); sp[2] += bf_lo(v.y); sp[3] += bf_hi(v.y); sp[4] += bf_lo(v.z); sp[5] += bf_hi(v.z); sp[6] += bf_lo(v.w); sp[7] += bf_hi(v.w); }
        else if (SAMPLE) { const float* q = BUFM + (size_t)(seq * 15 + 15 + t) * 1024 + c0;
#pragma unroll
            for (int j = 0; j < 8; ++j) sp[j] += q[j]; } }
#pragma unroll
    for (int k = 1; k <= 2; ++k) { const int t = t0 - k; float tmp[8];
        if (t >= 0) { const u32x4 v = *(const u32x4*)(U + (size_t)(rowbase + t) * 1024 + c0);
            tmp[0] = bf_lo(v.x); tmp[1] = bf_hi(v.x); tmp[2] = bf_lo(v.y); tmp[3] = bf_hi(v.y); tmp[4] = bf_lo(v.z); tmp[5] = bf_hi(v.z); tmp[6] = bf_lo(v.w); tmp[7] = bf_hi(v.w); }
        else if (SAMPLE) { const float* q = p.sconv + (size_t)(seq * 2 + 2 + t) * 1024 + c0;
#pragma unroll
            for (int j = 0; j < 8; ++j) tmp[j] = q[j]; }
        else {
#pragma unroll
            for (int j = 0; j < 8; ++j) tmp[j] = 0.f; }
#pragma unroll
        for (int j = 0; j < 8; ++j) { if (k == 1) um1[j] = tmp[j]; else um2[j] = tmp[j]; } }
#pragma unroll 2
    for (int s = 0; s < nT; ++s) { const int t = t0 + s; const size_t ro = (size_t)(rowbase + t) * 1024 + c0;
        const u32x4 xv = *(const u32x4*)(XM + ro), sv = *(const u32x4*)(SA + ro), uv = *(const u32x4*)(U + ro), gv = *(const u32x4*)(G2 + ro);
        float xo[8]; const int to = t - (w - 1);
        if (to >= 0) { const u32x4 v = *(const u32x4*)(XM + (size_t)(rowbase + to) * 1024 + c0);
            xo[0] = bf_lo(v.x); xo[1] = bf_hi(v.x); xo[2] = bf_lo(v.y); xo[3] = bf_hi(v.y); xo[4] = bf_lo(v.z); xo[5] = bf_hi(v.z); xo[6] = bf_lo(v.w); xo[7] = bf_hi(v.w); }
        else if (SAMPLE) { const float* q = BUFM + (size_t)(seq * 15 + 15 + to) * 1024 + c0;
#pragma unroll
            for (int j = 0; j < 8; ++j) xo[j] = q[j]; }
        else {
#pragma unroll
            for (int j = 0; j < 8; ++j) xo[j] = 0.f; }
        const float xc[8] = {bf_lo(xv.x), bf_hi(xv.x), bf_lo(xv.y), bf_hi(xv.y), bf_lo(xv.z), bf_hi(xv.z), bf_lo(xv.w), bf_hi(xv.w)};
        const float sa[8] = {bf_lo(sv.x), bf_hi(sv.x), bf_lo(sv.y), bf_hi(sv.y), bf_lo(sv.z), bf_hi(sv.z), bf_lo(sv.w), bf_hi(sv.w)};
        const float uc[8] = {bf_lo(uv.x), bf_hi(uv.x), bf_lo(uv.y), bf_hi(uv.y), bf_lo(uv.z), bf_hi(uv.z), bf_lo(uv.w), bf_hi(uv.w)};
        const float g2[8] = {bf_lo(gv.x), bf_hi(gv.x), bf_lo(gv.y), bf_hi(gv.y), bf_lo(gv.z), bf_hi(gv.z), bf_lo(gv.w), bf_hi(gv.w)};
        const int cnt = SAMPLE ? w : ((t + 1) < w ? (t + 1) : w);
        const float inv = 1.0f / (float)cnt;
        float ya[8], yb[8];
#pragma unroll
        for (int j = 0; j < 8; ++j) { const float S = sp[j] + xc[j]; ya[j] = (S * inv - xc[j]) * sc[j] * sa[j]; sp[j] = S - xo[j];
            yb[j] = g2[j] * (w0[j] * um2[j] + w1[j] * um1[j] + w2[j] * uc[j]); um2[j] = um1[j]; um1[j] = uc[j]; }
        u32x4 wa, wb;
        wa.x = pk_bf16(ya[0], ya[1]); wa.y = pk_bf16(ya[2], ya[3]); wa.z = pk_bf16(ya[4], ya[5]); wa.w = pk_bf16(ya[6], ya[7]);
        wb.x = pk_bf16(yb[0], yb[1]); wb.y = pk_bf16(yb[2], yb[3]); wb.z = pk_bf16(yb[4], yb[5]); wb.w = pk_bf16(yb[6], yb[7]);
        bf16_t* yo = YC + (size_t)(rowbase + t) * LDP + c0;
        *(u32x4*)yo = wa; *(u32x4*)(yo + 1024) = wb; }
}

__device__ __forceinline__ void phase2(const Params& p) {
    int t_ = threadIdx.x; asm volatile("" : "+v"(t_));
    const int NT = gridDim.x * NTHREADS, gt = blockIdx.x * NTHREADS + t_;
    for (int id = gt; id < 131072; id += NT) { const int cg8 = id & 127, run = id >> 7; stencil_run<false>(p, run >> 8, (run & 255) * 32, 32, cg8 * 8); }
    for (int id = gt; id < 131072; id += NT) { const int cg8 = id & 127, run = id >> 7; stencil_run<true>(p, run >> 5, (run & 31) * 2, 2, cg8 * 8); }
}

template <int NR>
__device__ __forceinline__ void p5_rows(const Params& p, const bf16_t* __restrict__ DL, int r, int nw, int lane) {
    f32x4 v[NR][8]; u32x4 d[NR][4];
#pragma unroll
    for (int k = 0; k < NR; ++k) { const int row = r + k * nw; const float* x = row < TP ? p.xp + (size_t)row * D : p.xs + (size_t)(row - TP) * D;
#pragma unroll
        for (int i = 0; i < 4; ++i) { v[k][2 * i] = *(const f32x4*)(x + (i * 64 + lane) * 8); v[k][2 * i + 1] = *(const f32x4*)(x + (i * 64 + lane) * 8 + 4);
            d[k][i] = *(const u32x4*)(DL + (size_t)row * LDP + (i * 64 + lane) * 8); } }
#pragma unroll
    for (int k = 0; k < NR; ++k) { const int row = r + k * nw; float ss = 0.f;
#pragma unroll
        for (int i = 0; i < 4; ++i) { const u32x4 w = d[k][i];
            v[k][2 * i] += (f32x4){bf_lo(w.x), bf_hi(w.x), bf_lo(w.y), bf_hi(w.y)}; v[k][2 * i + 1] += (f32x4){bf_lo(w.z), bf_hi(w.z), bf_lo(w.w), bf_hi(w.w)}; }
#pragma unroll
        for (int i = 0; i < 8; ++i) ss += (v[k][i][0] * v[k][i][0] + v[k][i][1] * v[k][i][1]) + (v[k][i][2] * v[k][i][2] + v[k][i][3] * v[k][i][3]);
#pragma unroll
        for (int o = 32; o >= 1; o >>= 1) ss += __shfl_xor(ss, o);
        const float rs = rsqrtf(ss * (1.0f / D) + EPS);
        float* y = p.out + O_Y + (size_t)row * D;
#pragma unroll
        for (int i = 0; i < 4; ++i) { const f32x4 g0 = *(const f32x4*)(p.fng + (i * 64 + lane) * 8), g1 = *(const f32x4*)(p.fng + (i * 64 + lane) * 8 + 4);
            *(f32x4*)(y + (i * 64 + lane) * 8) = v[k][2 * i] * rs * g0; *(f32x4*)(y + (i * 64 + lane) * 8 + 4) = v[k][2 * i + 1] * rs * g1; } }
}
__device__ __forceinline__ void phase5(const Params& p) {
    int t_ = threadIdx.x; asm volatile("" : "+v"(t_));
    const int lane = t_ & 63, gw = blockIdx.x * 8 + (t_ >> 6), nw = gridDim.x * 8;
    const bf16_t* DL = (const bf16_t*)(p.ws + WS_H);
    int r = gw;
    for (; r + nw < T; r += 2 * nw) p5_rows<2>(p, DL, r, nw, lane);
    if (r < T) p5_rows<1>(p, DL, r, nw, lane);
}


#define XB_TMO      128
#define XB_XCNT(j)  (256  + 64 * (j))
#define XB_XSUB(j)  (1280 + 64 * (j))
#define XB_XGEN(j)  (2304 + 64 * (j))
#define XB_TOP      3328
#define XB_TOPGEN   3392
#define XCD_BAR_WORDS 3456
#define XB_SPIN_CAP (1u << 18)
__device__ __forceinline__ unsigned xb_ld(unsigned* p)              { return __hip_atomic_load(p, __ATOMIC_RELAXED, __HIP_MEMORY_SCOPE_AGENT); }
__device__ __forceinline__ unsigned xb_add(unsigned* p, unsigned v) { return __hip_atomic_fetch_add(p, v, __ATOMIC_RELAXED, __HIP_MEMORY_SCOPE_AGENT); }
__device__ __forceinline__ unsigned xb_xcc_id() { return (unsigned)__builtin_amdgcn_s_getreg((3 << 11) | 20) & 0xFu; }
#define XB_SPIN(cond, bar) do { unsigned _sp = 0; while (cond) { __builtin_amdgcn_s_sleep(1); \
    if ((++_sp & 255u) == 0u) { if (xb_ld(&(bar)[XB_TMO])) break; if (_sp > XB_SPIN_CAP) { atomicAdd(&(bar)[XB_TMO], 1u); break; } } } } while (0)
struct XcdBarrier { unsigned* bar; unsigned x; volatile LAS unsigned* st; };
__device__ __forceinline__ XcdBarrier xcd_barrier_post(unsigned* bar, volatile LAS unsigned* st) {
    XcdBarrier b; b.bar = bar; b.x = xb_xcc_id(); b.st = st;
    if (threadIdx.x == 0) (void)xb_add(&bar[XB_XCNT(b.x)], 1u);
    return b;
}
__device__ __forceinline__ void xcd_barrier_complete(unsigned* bar, unsigned x, unsigned& nloc, unsigned& nx) {
    const unsigned G = gridDim.x * gridDim.y * gridDim.z;
    unsigned sum, cnt, mine, sp = 0u;
    for (;;) {
        sum = 0u; cnt = 0u; mine = 0u;
#pragma unroll
        for (unsigned j = 0; j < 16; ++j) { const unsigned c = xb_ld(&bar[XB_XCNT(j)]); sum += c; cnt += (c > 0u) ? 1u : 0u; mine = (j == x) ? c : mine; }
        if (sum == G) break;
        __builtin_amdgcn_s_sleep(1);
        if ((++sp & 255u) == 0u) { if (xb_ld(&bar[XB_TMO])) break; if (sp > XB_SPIN_CAP) { atomicAdd(&bar[XB_TMO], 1u); break; } }
    }
    nloc = mine > 0u ? mine : 1u; nx = cnt > 0u ? cnt : 1u;
}
__device__ __forceinline__ void xcd_barrier(const XcdBarrier& b) {
    asm volatile("s_waitcnt vmcnt(0)" ::: "memory");
    __syncthreads();
    if (threadIdx.x == 0) {
        unsigned* bar = b.bar;
        __builtin_amdgcn_s_waitcnt(0);
        unsigned nloc = b.st[0], nx = b.st[1];
        if (nloc == 0u) { xcd_barrier_complete(bar, b.x, nloc, nx); b.st[0] = nloc; b.st[1] = nx; }
        const unsigned old = xb_add(&bar[XB_XSUB(b.x)], 1u);
        const unsigned gen = old / nloc;
        if (old + 1u == (gen + 1u) * nloc) {
            __builtin_amdgcn_fence(__ATOMIC_RELEASE, "agent");
            asm volatile("s_waitcnt vmcnt(0)" ::: "memory");
            const unsigned og = xb_add(&bar[XB_TOP], 1u);
            const unsigned tg = og / nx;
            if (og + 1u == (tg + 1u) * nx) xb_add(&bar[XB_TOPGEN], 1u);
            else XB_SPIN(xb_ld(&bar[XB_TOPGEN]) == tg, bar);
            __builtin_amdgcn_fence(__ATOMIC_ACQUIRE, "agent");
            xb_add(&bar[XB_XGEN(b.x)], 1u);
            asm volatile("s_waitcnt vmcnt(0)" ::: "memory");
        } else {
            XB_SPIN(xb_ld(&bar[XB_XGEN(b.x)]) == gen, bar);
            __builtin_amdgcn_fence(__ATOMIC_ACQUIRE, "agent");
            asm volatile("s_waitcnt vmcnt(0)" ::: "memory");
        }
    }
    __syncthreads();
}

__global__ void __launch_bounds__(NTHREADS, 2) fwd_megakernel(Params p) {
    extern __shared__ __attribute__((aligned(16))) unsigned char lds_raw[];
    LAS unsigned char* lds = (LAS unsigned char*)lds_raw;
    const int G = gridDim.x, c = blockIdx.x;
    volatile LAS unsigned* xst = (volatile LAS unsigned*)(lds + STAGE_BYTES);
    unsigned* barw = (unsigned*)(p.ws + WS_BAR);
    if (threadIdx.x < 2) xst[threadIdx.x] = 0u;
    __syncthreads();
    const XcdBarrier xb = xcd_barrier_post(barw, xst);

    phase_colmax(p, lds);
    xcd_barrier(xb);
    phase0(p, lds);
    xcd_barrier(xb);
    {
        { EpiI8 E8{(bf16_t*)(p.ws + WS_SA), (bf16_t*)(p.ws + WS_U), (bf16_t*)(p.ws + WS_G2), (const float*)(p.ws + WS_RSC), (const float*)(p.ws + WS_CSV)};
          GemmDesc g{(const bf16_t*)(p.ws + WS_H8I), (const bf16_t*)(p.ws + WS_BIN8I - (size_t)4 * 256 * LD8), LD8 / 2, LD8 / 2, 16, nullptr, nullptr}; Sched1c S{G, c}; gemm_phase<2>(lds, g, S, E8); }
    }
    xcd_barrier(xb);
    phase2(p);
    {
        GemmDesc g{(const bf16_t*)(p.ws + WS_H8), (const bf16_t*)(p.ws + WS_BIN8 - (size_t)24 * 256 * LD8), LD8 / 2, LD8 / 2, 16, nullptr, nullptr}; Sched1b S{G, c};
        EpiGG EG{(bf16_t*)(p.ws + WS_SGR), (bf16_t*)(p.ws + WS_SGB), p.bgate, 1.0f / W8_SCALE}; gemm_phase<1>(lds, g, S, EG);
    }
    xcd_barrier(xb);
    {
        GemmDesc g{(const bf16_t*)(p.ws + WS_H), (const bf16_t*)(p.ws + WS_BP), LDP, LDP, 16, (const bf16_t*)(p.ws + WS_MG), (const bf16_t*)(p.ws + WS_BO)};
        EpiMix E{EpiD{(const bf16_t*)(p.ws + WS_SGR), (const bf16_t*)(p.ws + WS_SGB), (bf16_t*)(p.ws + WS_MG)}, EpiE{(bf16_t*)(p.ws + WS_H)}};
        { SchedA S{G, c}; gemm_phase<0>(lds, g, S, E); }
        xcd_barrier(xb);
        { SchedB S{G, c}; gemm_phase<0>(lds, g, S, E); }
        xcd_barrier(xb);
        { SchedC S{G, c}; gemm_phase<0>(lds, g, S, E); }
        {
            Epi1 E1{(bf16_t*)(p.ws + WS_XM), (bf16_t*)(p.ws + WS_SA), (bf16_t*)(p.ws + WS_U), (bf16_t*)(p.ws + WS_G2), p.out};
            GemmDesc g1{(const bf16_t*)(p.ws + WS_HX), (const bf16_t*)(p.ws + WS_BIN), LDP, LDP, 32, (const bf16_t*)(p.ws + WS_HG), (const bf16_t*)(p.ws + WS_BIN)};
            Sched1a S1{G, (c + G - 128 % G) % G}; gemm_phase<0>(lds, g1, S1, E1); }
    }
    xcd_barrier(xb);
    phase5(p);
}

extern "C" void kernel_launch(void* const* d_in, const int* in_sizes, int n_in, void* d_out, int out_size, void* d_ws, size_t ws_size, hipStream_t stream) {
    static int grid_blocks = 0;
    if (grid_blocks == 0) {
        if (ws_size < WS_END) { fprintf(stderr, "kernel_launch: workspace too small: %zu < %zu\n", ws_size, (size_t)WS_END); grid_blocks = -1; return; }
        int dev = 0, cus = 0, per_cu = 0;
        hipGetDevice(&dev);
        hipDeviceGetAttribute(&cus, hipDeviceAttributeMultiprocessorCount, dev);
        if (hipFuncSetAttribute((const void*)fwd_megakernel, hipFuncAttributeMaxDynamicSharedMemorySize, LDS_BYTES) != hipSuccess) { fprintf(stderr, "kernel_launch: hipFuncSetAttribute failed\n"); grid_blocks = -1; return; }
        if (hipOccupancyMaxActiveBlocksPerMultiprocessor(&per_cu, (const void*)fwd_megakernel, NTHREADS, LDS_BYTES) != hipSuccess || per_cu < 1) { fprintf(stderr, "kernel_launch: occupancy query failed (%d)\n", per_cu); (void)hipGetLastError(); per_cu = 1; }
        grid_blocks = cus * per_cu;
        if (grid_blocks > 256) grid_blocks = 256;
    }
    if (grid_blocks < 0) return;
    Params p{};
    p.xp = (const float*)d_in[0]; p.xs = (const float*)d_in[1]; p.spool = (const float*)d_in[2]; p.sconv = (const float*)d_in[3]; p.ng = (const float*)d_in[4];
    p.win = (const float*)d_in[5]; p.bgate = (const float*)d_in[6]; p.wmix = (const float*)d_in[7]; p.pscale = (const float*)d_in[8]; p.wconv = (const float*)d_in[9];
    p.wpp = (const float*)d_in[10]; p.wpc = (const float*)d_in[11]; p.wout = (const float*)d_in[12]; p.fng = (const float*)d_in[13];
    p.out = (float*)d_out; p.ws = (unsigned char*)d_ws;
    if (hipMemsetAsync((char*)d_ws + WS_BAR, 0, ZERO_BYTES, stream) != hipSuccess) { fprintf(stderr, "kernel_launch: hipMemsetAsync of the barrier words failed\n"); return; }
    void* args[] = {&p};
    hipError_t e = hipLaunchCooperativeKernel((const void*)fwd_megakernel, dim3(grid_blocks), dim3(NTHREADS), args, LDS_BYTES, stream);
    if (e != hipSuccess) fprintf(stderr, "cooperative launch failed: %s (grid %d)\n", hipGetErrorString(e), grid_blocks);
}
```
